# Optimizing an MI355X kernel written in HIP

```python
import math
import jax
import jax.numpy as jnp
from jax import lax
import numpy as np

D_MODEL = 1024
BATCH = 8
SEQ = 2048
DEPTH = 2

CONV_A_GROUPS = 4
CONV_A_GROUP_DIM = 64
D_CONV_A = CONV_A_GROUPS * CONV_A_GROUP_DIM
CONV_A_WIDTH = 3
SSD_HEADS = 6
SSD_HEAD_DIM = 64
D_SSD = SSD_HEADS * SSD_HEAD_DIM
SSD_GROUPS = 2
SSD_STATE = 128
SSD_CONV_WIDTH = 4
SSD_CHUNK = 128
SSD_CONV_DIM = D_SSD + 2 * SSD_GROUPS * SSD_STATE
SSD_NORM_EPS = 1e-5
MLA_HEADS = 6
Q_LORA = 256
KV_LORA = 128
QK_NOPE = 64
QK_ROPE = 32
V_DIM = 64
D_MLA = MLA_HEADS * V_DIM
ROPE_BASE = 10000.0
Q_BLOCK = 128
D_MIX = D_CONV_A + D_SSD + D_MLA
NORM_EPS = 1e-6
POS_OFFSET_MAX = 1024
SPLIT_SIZES = (D_CONV_A, D_CONV_A, D_CONV_A, D_CONV_A,
               D_SSD, D_SSD, SSD_GROUPS * SSD_STATE, SSD_GROUPS * SSD_STATE, SSD_HEADS,
               Q_LORA, KV_LORA, QK_ROPE, D_MLA)
IN_COLS = sum(SPLIT_SIZES)

kernel_name = 'hybrid_conv_ssd_mla_parallel'


def rmsnorm(x, g, eps=NORM_EPS):
    xf = x.astype(jnp.float32)
    y = xf * lax.rsqrt(jnp.mean(xf * xf, axis=-1, keepdims=True) + eps)
    return (y * g.astype(jnp.float32)).astype(x.dtype)


def causal_depthwise_conv(u, w):
    k, c = w.shape
    return lax.conv_general_dilated(
        u, w[:, None, :].astype(u.dtype), window_strides=(1,), padding=[(k - 1, 0)],
        dimension_numbers=('NWC', 'WIO', 'NWC'), feature_group_count=c)


def apply_rope(t, cos, sin):
    tf = t.astype(jnp.float32)
    t1, t2 = jnp.split(tf, 2, axis=-1)
    return jnp.concatenate([t1 * cos - t2 * sin, t2 * cos + t1 * sin], axis=-1).astype(t.dtype)


def short_conv_branch(a_h, a_b, a_c, a_z, conv_w):
    return a_b * causal_depthwise_conv(a_c * a_h, conv_w) * jax.nn.silu(a_z)


def segsum_exp(a_cs):
    l = a_cs.shape[-1]
    diff = a_cs[..., :, None] - a_cs[..., None, :]
    mask = jnp.tril(jnp.ones((l, l), dtype=bool))
    return jnp.exp(jnp.where(mask, diff, -jnp.inf))


def ssd_chunked(xh, dt, a, bh, ch):
    b, s, h, p = xh.shape
    n = bh.shape[-1]
    nc = s // SSD_CHUNK
    la = (dt * a).reshape(b, nc, SSD_CHUNK, h).transpose(0, 3, 1, 2)
    xd = (xh * dt[..., None]).reshape(b, nc, SSD_CHUNK, h, p)
    bc = bh.reshape(b, nc, SSD_CHUNK, h, n)
    cc = ch.reshape(b, nc, SSD_CHUNK, h, n)
    a_cs = jnp.cumsum(la, axis=-1)
    scores = jnp.einsum('bclhn,bcshn->bhcls', cc, bc) * segsum_exp(a_cs)
    y_diag = jnp.einsum('bhcls,bcshp->bclhp', scores, xd)
    decay_states = jnp.exp(a_cs[..., -1:] - a_cs)
    states = jnp.einsum('bclhn,bhcl,bclhp->bchpn', bc, decay_states, xd)
    chunk_decay = jnp.exp(a_cs[..., -1])

    def step(carry, inp):
        st, dec = inp
        return carry * dec[..., None, None] + st, carry

    init = jnp.zeros((b, h, p, n), dtype=xd.dtype)
    _, prev = lax.scan(step, init, (jnp.moveaxis(states, 1, 0), jnp.moveaxis(chunk_decay, 2, 0)))
    prev = jnp.moveaxis(prev, 0, 1)
    y_off = jnp.einsum('bclhn,bchpn,bhcl->bclhp', cc, prev, jnp.exp(a_cs))
    return (y_diag + y_off).reshape(b, s, h, p)


def ssd_branch(s_z, s_x, s_b, s_c, s_dt, conv_w, conv_b, dt_bias, a_log, d_skip, norm_g):
    b, s, _ = s_x.shape
    f32 = jnp.float32
    xbc = jnp.concatenate([s_x, s_b, s_c], axis=-1)
    xbc = jax.nn.silu(causal_depthwise_conv(xbc, conv_w) + conv_b)
    xs, bs, cs = jnp.split(xbc, [D_SSD, D_SSD + SSD_GROUPS * SSD_STATE], axis=-1)
    rep = SSD_HEADS // SSD_GROUPS
    xh = xs.reshape(b, s, SSD_HEADS, SSD_HEAD_DIM).astype(f32)
    bh = jnp.repeat(bs.reshape(b, s, SSD_GROUPS, SSD_STATE), rep, axis=2).astype(f32)
    ch = jnp.repeat(cs.reshape(b, s, SSD_GROUPS, SSD_STATE), rep, axis=2).astype(f32)
    dt = jax.nn.softplus(s_dt.astype(f32) + dt_bias.astype(f32))
    a = -jnp.exp(a_log.astype(f32))
    y = ssd_chunked(xh, dt, a, bh, ch) + xh * d_skip.astype(f32)[:, None]
    y = y.reshape(b, s, D_SSD).astype(s_x.dtype)
    g = (y * jax.nn.silu(s_z)).reshape(b, s, SSD_GROUPS, D_SSD // SSD_GROUPS)
    g = rmsnorm(g, norm_g.reshape(SSD_GROUPS, D_SSD // SSD_GROUPS), SSD_NORM_EPS)
    return g.reshape(b, s, D_SSD)


def causal_block_attention(q_nope, q_rope, k_nope, k_rope, v):
    b, s, h, _ = q_nope.shape
    nb = s // Q_BLOCK
    scale = (QK_NOPE + QK_ROPE) ** -0.5
    kpos = jnp.arange(s)

    def to_blocks(t):
        return jnp.swapaxes(t.reshape(b, nb, Q_BLOCK, *t.shape[2:]), 0, 1)

    def one_block(args):
        qn, qr, start = args
        sc = (jnp.einsum('bqhd,bkhd->bhqk', qn, k_nope)
              + jnp.einsum('bqhr,bkr->bhqk', qr, k_rope)).astype(jnp.float32) * scale
        qpos = start + jnp.arange(Q_BLOCK)
        mask = kpos[None, :] <= qpos[:, None]
        pr = jax.nn.softmax(jnp.where(mask, sc, -jnp.inf), axis=-1).astype(v.dtype)
        return jnp.einsum('bhqk,bkhd->bqhd', pr, v)

    out = lax.map(one_block, (to_blocks(q_nope), to_blocks(q_rope), jnp.arange(nb) * Q_BLOCK))
    return jnp.swapaxes(out, 0, 1).reshape(b, s, h, v.shape[-1])


def mla_branch(c_qa, c_kv, c_kr, c_z, cos, sin, q_norm_g, w_qb, kv_norm_g, w_kvb):
    b, s, _ = c_qa.shape
    q = jnp.einsum('bsr,rc->bsc', rmsnorm(c_qa, q_norm_g), w_qb).reshape(b, s, MLA_HEADS, QK_NOPE + QK_ROPE)
    q_nope, q_rope = jnp.split(q, [QK_NOPE], axis=-1)
    q_rope = apply_rope(q_rope, cos[:, :, None, :], sin[:, :, None, :])
    kv = jnp.einsum('bsr,rc->bsc', rmsnorm(c_kv, kv_norm_g), w_kvb).reshape(b, s, MLA_HEADS, QK_NOPE + V_DIM)
    k_nope, v = jnp.split(kv, [QK_NOPE], axis=-1)
    k_rope = apply_rope(c_kr, cos, sin)
    o = causal_block_attention(q_nope, q_rope, k_nope, k_rope, v)
    return o.reshape(b, s, D_MLA) * jax.nn.silu(c_z)


def hybrid_layer(x, cos, sin, norm_g, w_in, conv_a_w, ssd_conv_w, ssd_conv_b, ssd_dt_bias,
                 ssd_a_log, ssd_d, ssd_norm_g, mla_q_norm_g, w_qb, mla_kv_norm_g, w_kvb, w_out):
    h = rmsnorm(x, norm_g)
    proj = jnp.einsum('bsd,dc->bsc', h, w_in)
    split_at = np.cumsum(SPLIT_SIZES)[:-1].tolist()
    (a_h, a_b, a_c, a_z, s_z, s_x, s_b, s_c, s_dt,
     c_qa, c_kv, c_kr, c_z) = jnp.split(proj, split_at, axis=-1)
    y_a = short_conv_branch(a_h, a_b, a_c, a_z, conv_a_w)
    y_b = ssd_branch(s_z, s_x, s_b, s_c, s_dt, ssd_conv_w, ssd_conv_b, ssd_dt_bias,
                     ssd_a_log, ssd_d, ssd_norm_g)
    y_c = mla_branch(c_qa, c_kv, c_kr, c_z, cos, sin, mla_q_norm_g, w_qb, mla_kv_norm_g, w_kvb)
    y = jnp.concatenate([y_a, y_b, y_c], axis=-1)
    return x + jnp.einsum('bsm,md->bsd', y, w_out)


def setup_inputs(seed: int = 0) -> dict:
    key = jax.random.key(seed)
    ks = jax.random.split(key, 20)
    f32 = jnp.float32
    nrm = jax.random.normal
    x = nrm(ks[0], (BATCH, SEQ, D_MODEL), f32)
    offs = jax.random.randint(ks[1], (BATCH, 1), 0, POS_OFFSET_MAX, dtype=jnp.int32)
    positions = (offs + jnp.arange(SEQ, dtype=jnp.int32)[None, :]).astype(jnp.int32)
    norm_g = 1.0 + 0.02 * nrm(ks[2], (DEPTH, D_MODEL), f32)
    w_in = nrm(ks[3], (DEPTH, D_MODEL, IN_COLS), f32) * D_MODEL ** -0.5
    conv_a_w = nrm(ks[4], (DEPTH, CONV_A_WIDTH, D_CONV_A), f32) * CONV_A_WIDTH ** -0.5
    ssd_conv_w = nrm(ks[5], (DEPTH, SSD_CONV_WIDTH, SSD_CONV_DIM), f32) * SSD_CONV_WIDTH ** -0.5
    ssd_conv_b = 0.01 * nrm(ks[6], (DEPTH, SSD_CONV_DIM), f32)
    u = jax.random.uniform(ks[7], (DEPTH, SSD_HEADS), f32)
    dt0 = jnp.exp(u * (math.log(0.1) - math.log(0.001)) + math.log(0.001))
    ssd_dt_bias = dt0 + jnp.log(-jnp.expm1(-dt0))
    ssd_a_log = jnp.log(jax.random.uniform(ks[8], (DEPTH, SSD_HEADS), f32, 1.0, 16.0))
    ssd_d = 1.0 + 0.1 * nrm(ks[9], (DEPTH, SSD_HEADS), f32)
    ssd_norm_g = 1.0 + 0.02 * nrm(ks[10], (DEPTH, D_SSD), f32)
    mla_q_norm_g = 1.0 + 0.02 * nrm(ks[11], (DEPTH, Q_LORA), f32)
    w_qb = nrm(ks[12], (DEPTH, Q_LORA, MLA_HEADS * (QK_NOPE + QK_ROPE)), f32) * Q_LORA ** -0.5
    mla_kv_norm_g = 1.0 + 0.02 * nrm(ks[13], (DEPTH, KV_LORA), f32)
    w_kvb = nrm(ks[14], (DEPTH, KV_LORA, MLA_HEADS * (QK_NOPE + V_DIM)), f32) * KV_LORA ** -0.5
    w_out = nrm(ks[15], (DEPTH, D_MIX, D_MODEL), f32) * D_MIX ** -0.5
    final_norm_g = 1.0 + 0.02 * nrm(ks[16], (D_MODEL,), f32)
    return {'x': x, 'positions': positions, 'norm_g': norm_g, 'w_in': w_in, 'conv_a_w': conv_a_w,
            'ssd_conv_w': ssd_conv_w, 'ssd_conv_b': ssd_conv_b, 'ssd_dt_bias': ssd_dt_bias,
            'ssd_a_log': ssd_a_log, 'ssd_d': ssd_d, 'ssd_norm_g': ssd_norm_g,
            'mla_q_norm_g': mla_q_norm_g, 'w_qb': w_qb, 'mla_kv_norm_g': mla_kv_norm_g,
            'w_kvb': w_kvb, 'w_out': w_out, 'final_norm_g': final_norm_g}


def reference(x, positions, norm_g, w_in, conv_a_w, ssd_conv_w, ssd_conv_b, ssd_dt_bias,
              ssd_a_log, ssd_d, ssd_norm_g, mla_q_norm_g, w_qb, mla_kv_norm_g, w_kvb, w_out,
              final_norm_g):
    inv_freq = ROPE_BASE ** (-jnp.arange(0, QK_ROPE, 2, dtype=jnp.float32) / QK_ROPE)
    ang = positions.astype(jnp.float32)[..., None] * inv_freq
    cos, sin = jnp.cos(ang), jnp.sin(ang)
    for l in range(DEPTH):
        x = hybrid_layer(x, cos, sin, norm_g[l], w_in[l], conv_a_w[l], ssd_conv_w[l], ssd_conv_b[l],
                         ssd_dt_bias[l], ssd_a_log[l], ssd_d[l], ssd_norm_g[l], mla_q_norm_g[l],
                         w_qb[l], mla_kv_norm_g[l], w_kvb[l], w_out[l])
    return rmsnorm(x, final_norm_g)
```

```cpp
#include <hip/hip_runtime.h>
#include <cstdio>
#include <cstdint>

#ifndef MK_N_LAUNCHES
#define MK_N_LAUNCHES 1
#endif

constexpr int BATCH = 8, SEQ = 2048, DM = 1024, DEPTH = 2, T = BATCH * SEQ;
constexpr int IN_COLS = 3110;
constexpr int NP = 3328;
constexpr int PC_AH = 0, PC_AB = 256, PC_AC = 512, PC_AZ = 768, PC_SZ = 1024, PC_SX = 1408, PC_SB = 1792, PC_SC = 2048,
              PC_CZ = 2304, PC_QA = 2816, PC_KV = 3072, PC_KR = 3200, PC_DT = 3232;
constexpr int NQKV = 1536;
constexpr int QC_QN = 0, QC_QR = 384, QC_KN = 768, QC_V = 1152;
constexpr int YC_A = 0, YC_B = 256, YC_C = 640;
constexpr int NHEAD = 6, SSD_H = 6, SSD_P = 64, SSD_N = 128, SSD_G = 2, CHUNK = 128, NCHUNK = SEQ / CHUNK;
constexpr float NORM_EPS = 1e-6f, SSD_NORM_EPS = 1e-5f;
constexpr float ATT_C2 = 0.10206207261596577f * 1.4426950408889634f;

constexpr size_t MiB = 1u << 20;
constexpr size_t WS_CTL = 0, CTL_ZERO_BYTES = 64 * 1024;
constexpr size_t WS_WIN = 1 * MiB;
constexpr size_t WS_WQKV = WS_WIN + (size_t)DEPTH * NP * DM * 2;
constexpr size_t WS_WOUT = WS_WQKV + (size_t)DEPTH * NQKV * 256 * 2;
constexpr size_t WS_CS = WS_WOUT + (size_t)DEPTH * DM * DM * 2;
constexpr size_t WS_DT = WS_CS + (size_t)T * 32 * 4;
constexpr size_t WS_SSQ = WS_DT + (size_t)T * 8 * 4;
constexpr size_t WS_CDEC = WS_SSQ + (size_t)4 * T * 4;
constexpr size_t WS_XRES = 24 * MiB;
constexpr size_t WS_PROJ = WS_XRES + (size_t)T * DM * 4;
constexpr size_t WS_Y = WS_PROJ + (size_t)T * NP * 2;
constexpr size_t WS_ST = WS_Y + (size_t)T * DM * 2;
constexpr size_t WS_END = WS_ST + (size_t)T * 384 * 4;
static_assert(WS_CDEC + (size_t)BATCH * NCHUNK * 8 * 4 <= WS_XRES, "ws map (small)");
static_assert(WS_END <= 256 * MiB, "ws map");
constexpr size_t DO_QKV = 0;
constexpr size_t DO_XB = 0;
constexpr size_t DO_TMP = 32 * MiB;

constexpr int CW_TMO = 0, CW_BAR = 1024, CW_Q = 8192;

constexpr int RING_BYTES = 131072, XCH_OFF = RING_BYTES, XCH_BYTES = 8192, MISC_OFF = XCH_OFF + XCH_BYTES, LDS_BYTES = 147456;
constexpr int NWAVES = 8, NTHR = NWAVES * 64;

#define GAS __attribute__((address_space(1)))
#define LAS __attribute__((address_space(3)))
typedef unsigned short bf16;
typedef unsigned v4u __attribute__((ext_vector_type(4)));
typedef unsigned v2u __attribute__((ext_vector_type(2)));
typedef float f32x4 __attribute__((ext_vector_type(4)));
typedef short bf16x8 __attribute__((ext_vector_type(8)));
typedef GAS unsigned gu32;
#define RLX_AGENT __ATOMIC_RELAXED, __HIP_MEMORY_SCOPE_AGENT
#define LDS_WAIT() asm volatile("s_waitcnt lgkmcnt(0)" ::: "memory")
#define VM_WAIT() asm volatile("s_waitcnt vmcnt(0)" ::: "memory")

__device__ __forceinline__ unsigned f2bf(float f) { unsigned u = __builtin_bit_cast(unsigned, f); return (u + 0x7fffu + ((u >> 16) & 1u)) >> 16; }
__device__ __forceinline__ unsigned pk2(float lo, float hi) { return f2bf(lo) | (f2bf(hi) << 16); }
__device__ __forceinline__ float bf2f(unsigned short b) { return __builtin_bit_cast(float, (unsigned)b << 16); }
__device__ __forceinline__ float bflo(unsigned w) { return __builtin_bit_cast(float, w << 16); }
__device__ __forceinline__ float bfhi(unsigned w) { return __builtin_bit_cast(float, w & 0xffff0000u); }
__device__ __forceinline__ float silu_f(float x) { return x / (1.f + __expf(-x)); }
__device__ __forceinline__ float softplus_f(float x) { return fmaxf(x, 0.f) + log1pf(__expf(-fabsf(x))); }

#define XB_TMO      128
#define XB_XCNT(j)  (256  + 64 * (j))
#define XB_XSUB(j)  (1280 + 64 * (j))
#define XB_XGEN(j)  (2304 + 64 * (j))
#define XB_TOP      3328
#define XB_TOPGEN   3392
#define XCD_BAR_WORDS 3456
#define XB_SPIN_CAP (1u << 22)
__device__ __forceinline__ unsigned xb_ld(unsigned* p)              { return __hip_atomic_load(p, __ATOMIC_RELAXED, __HIP_MEMORY_SCOPE_AGENT); }
__device__ __forceinline__ unsigned xb_add(unsigned* p, unsigned v) { return __hip_atomic_fetch_add(p, v, __ATOMIC_RELAXED, __HIP_MEMORY_SCOPE_AGENT); }
__device__ __forceinline__ unsigned xb_xcc_id() { return (unsigned)__builtin_amdgcn_s_getreg((3 << 11) | 20) & 0xFu; }
#define XB_SPIN(cond, bar) do { unsigned _sp = 0; while (cond) { __builtin_amdgcn_s_sleep(1); \
    if ((++_sp & 255u) == 0u) { if (xb_ld(&(bar)[XB_TMO])) break; if (_sp > XB_SPIN_CAP) { atomicAdd(&(bar)[XB_TMO], 1u); break; } } } } while (0)
struct XcdBarrier { unsigned* bar; unsigned x; volatile LAS unsigned* st; };
__device__ __forceinline__ XcdBarrier xcd_barrier_post(unsigned* bar, volatile LAS unsigned* st) {
    XcdBarrier b; b.bar = bar; b.x = xb_xcc_id(); b.st = st;
    if (threadIdx.x == 0) (void)xb_add(&bar[XB_XCNT(b.x)], 1u);
    return b;
}
__device__ __forceinline__ void xcd_barrier_complete(unsigned* bar, unsigned x, unsigned& nloc, unsigned& nx) {
    const unsigned G = gridDim.x * gridDim.y * gridDim.z;
    unsigned sum, cnt, mine, sp = 0u;
    for (;;) {
        sum = 0u; cnt = 0u; mine = 0u;
#pragma unroll
        for (unsigned j = 0; j < 16; ++j) { const unsigned c = xb_ld(&bar[XB_XCNT(j)]); sum += c; cnt += (c > 0u) ? 1u : 0u; mine = (j == x) ? c : mine; }
        if (sum == G) break;
        __builtin_amdgcn_s_sleep(1);
        if ((++sp & 255u) == 0u) { if (xb_ld(&bar[XB_TMO])) break; if (sp > XB_SPIN_CAP) { atomicAdd(&bar[XB_TMO], 1u); break; } }
    }
    nloc = mine > 0u ? mine : 1u; nx = cnt > 0u ? cnt : 1u;
}
__device__ __forceinline__ void xcd_barrier(const XcdBarrier& b) {
    asm volatile("s_waitcnt vmcnt(0)" ::: "memory");
    __syncthreads();
    if (threadIdx.x == 0) {
        unsigned* bar = b.bar;
        __builtin_amdgcn_s_waitcnt(0);
        unsigned nloc = b.st[0], nx = b.st[1];
        if (nloc == 0u) { xcd_barrier_complete(bar, b.x, nloc, nx); b.st[0] = nloc; b.st[1] = nx; }
        const unsigned old = xb_add(&bar[XB_XSUB(b.x)], 1u);
        const unsigned gen = old / nloc;
        if (old + 1u == (gen + 1u) * nloc) {
            __builtin_amdgcn_fence(__ATOMIC_RELEASE, "agent");
            asm volatile("s_waitcnt vmcnt(0)" ::: "memory");
            const unsigned og = xb_add(&bar[XB_TOP], 1u);
            const unsigned tg = og / nx;
            if (og + 1u == (tg + 1u) * nx) xb_add(&bar[XB_TOPGEN], 1u);
            else XB_SPIN(xb_ld(&bar[XB_TOPGEN]) == tg, bar);
            __builtin_amdgcn_fence(__ATOMIC_ACQUIRE, "agent");
            xb_add(&bar[XB_XGEN(b.x)], 1u);
            asm volatile("s_waitcnt vmcnt(0)" ::: "memory");
        } else {
            XB_SPIN(xb_ld(&bar[XB_XGEN(b.x)]) == gen, bar);
            __builtin_amdgcn_fence(__ATOMIC_ACQUIRE, "agent");
            asm volatile("s_waitcnt vmcnt(0)" ::: "memory");
        }
    }
    __syncthreads();
}

struct Args {
    const float* x; const int* pos; const float* norm_g; const float* w_in; const float* conv_a_w; const float* ssd_conv_w; const float* ssd_conv_b;
    const float* ssd_dt_bias; const float* ssd_a_log; const float* ssd_d; const float* ssd_norm_g; const float* mla_q_norm_g; const float* w_qb;
    const float* mla_kv_norm_g; const float* w_kvb; const float* w_out; const float* final_norm_g;
    float* out; unsigned char* ws; int ph_lo, ph_hi;
};
struct Frame {
    LAS unsigned char* lds; int tid, lane, wave, G, bid;
    unsigned char* ws; unsigned char* dout;
};
__device__ __forceinline__ float wave_sum(float v) {
#pragma unroll
    for (int o = 1; o < 64; o <<= 1) v += __shfl_xor(v, o);
    return v;
}

__device__ __forceinline__ int win_src_col(int n) {
    if (n < 2304) return n;
    if (n < 2688) return 2726 + (n - 2304);
    if (n < 2816) return -1;
    if (n < 3072) return 2310 + (n - 2816);
    if (n < 3200) return 2566 + (n - 3072);
    if (n < 3232) return 2694 + (n - 3200);
    if (n < 3238) return 2304 + (n - 3232);
    return -1;
}
__device__ __forceinline__ int wqkv_src_col(int n, int& which) {
    if (n < 384) { which = 0; return (n >> 6) * 96 + (n & 63); }
    if (n < 576) { which = 0; const int r = n - 384; return (r >> 5) * 96 + 64 + (r & 31); }
    if (n < 768) { which = -1; return -1; }
    if (n < 1152) { which = 1; const int r = n - 768; return (r >> 6) * 128 + (r & 63); }
    which = 1; const int r = n - 1152; return (r >> 6) * 128 + 64 + (r & 63);
}

template <class SrcFn>
__device__ __forceinline__ void transpose_item(const SrcFn& src, int K, bf16* WT, LAS float* scr, int kb, int nb, int lane) {
    const int k0 = 64 * kb, n0 = 32 * nb;
#pragma unroll 8
    for (int i = 0; i < 32; ++i) { const int kk = 2 * i + (lane >> 5); scr[kk * 33 + (lane & 31)] = src(k0 + kk, n0 + (lane & 31)); }
    LDS_WAIT(); asm volatile("" ::: "memory");
    const int c = lane & 7;
#pragma unroll
    for (int j = 0; j < 4; ++j) { const int n = (lane >> 3) + 8 * j; const LAS float* s = scr + (8 * c) * 33 + n;
        v4u o; o.x = pk2(s[0 * 33], s[1 * 33]); o.y = pk2(s[2 * 33], s[3 * 33]); o.z = pk2(s[4 * 33], s[5 * 33]); o.w = pk2(s[6 * 33], s[7 * 33]);
        *(GAS v4u*)(WT + (size_t)(n0 + n) * K + k0 + 8 * c) = o; }
    LDS_WAIT(); asm volatile("" ::: "memory");
}
__device__ __forceinline__ void p0_prologue(Frame& F, const Args& a) {
    LAS float* scr = (LAS float*)(F.lds + F.wave * 16384);
    const int gw = F.bid * NWAVES + F.wave, NGW = F.G * NWAVES;
    bf16* Win_t = (bf16*)(F.ws + WS_WIN); bf16* Wqkv_t = (bf16*)(F.ws + WS_WQKV); bf16* Wout_t = (bf16*)(F.ws + WS_WOUT);
    constexpr int I_IN = (DM / 64) * (NP / 32), I_QKV = (256 / 64) * (NQKV / 32), I_OUT = (DM / 64) * (DM / 32), I_L = I_IN + I_QKV + I_OUT;
    for (int it = gw; it < DEPTH * I_L; it += NGW) {
        const int l = it / I_L; int r = it % I_L;
        if (r < I_IN) {
            const float* W = a.w_in + (size_t)l * DM * IN_COLS; const float* g = a.norm_g + l * DM;
            auto src = [&](int k, int n) -> float { const int sc = win_src_col(n); return sc < 0 ? 0.f : W[(size_t)k * IN_COLS + sc] * g[k]; };
            transpose_item(src, DM, Win_t + (size_t)l * NP * DM, scr, r / (NP / 32), r % (NP / 32), F.lane); continue; }
        r -= I_IN;
        if (r < I_QKV) {
            const float* Wq = a.w_qb + (size_t)l * 256 * 576; const float* Wkv = a.w_kvb + (size_t)l * 128 * 768;
            const float* gq = a.mla_q_norm_g + l * 256; const float* gkv = a.mla_kv_norm_g + l * 128;
            auto src = [&](int k, int n) -> float { int which; const int sc = wqkv_src_col(n, which);
                if (which == 0) return Wq[(size_t)k * 576 + sc] * gq[k] * ATT_C2;
                if (which == 1) return k < 128 ? Wkv[(size_t)k * 768 + sc] * gkv[k] : 0.f;
                return 0.f; };
            transpose_item(src, 256, Wqkv_t + (size_t)l * NQKV * 256, scr, r / (NQKV / 32), r % (NQKV / 32), F.lane); continue; }
        r -= I_QKV;
        { const float* W = a.w_out + (size_t)l * DM * DM;
          auto src = [&](int k, int n) -> float { return W[(size_t)k * DM + n]; };
          transpose_item(src, DM, Wout_t + (size_t)l * DM * DM, scr, r / (DM / 32), r % (DM / 32), F.lane); }
    }
    bf16* xb = (bf16*)(F.dout + DO_XB); float* ssq = (float*)(F.ws + WS_SSQ);
    for (int m = gw; m < T; m += NGW) {
        const GAS f32x4* xr = (const GAS f32x4*)(a.x + (size_t)m * DM) + F.lane; GAS v2u* o8 = (GAS v2u*)(xb + (size_t)m * DM) + F.lane;
        float s = 0.f;
#pragma unroll
        for (int j = 0; j < 4; ++j) { const f32x4 v = xr[64 * j]; s += (v.x * v.x + v.y * v.y) + (v.z * v.z + v.w * v.w); v2u w; w.x = pk2(v.x, v.y); w.y = pk2(v.z, v.w); o8[64 * j] = w; }
        s = wave_sum(s);
        if (F.lane < 4) ssq[F.lane * T + m] = F.lane == 0 ? s : 0.f;
    }
    float* cs = (float*)(F.ws + WS_CS);
    for (int i = F.bid * NTHR + F.tid; i < T * 16; i += F.G * NTHR) {
        const int t = i >> 4, j = i & 15;
        const float inv = (float)pow(10000.0, -(double)(2 * j) / 32.0);
        const float ang = (float)a.pos[t] * inv;
        cs[(size_t)t * 32 + j] = cosf(ang); cs[(size_t)t * 32 + 16 + j] = sinf(ang);
    }
}

template <class Epi>
__device__ __forceinline__ void naive_gemm(Frame& F, const bf16* A, int lda, const bf16* Bt, int ldb, int M, int N, int K, const Epi& epi) {
    LAS float* As = (LAS float*)F.lds; LAS float* Bs = As + 32 * 132;
    const int tid = F.tid, ty = tid >> 4, tx = tid & 15;
    const int ntn = N / 64, nunits = (M / 128) * ntn;
    for (int u = F.bid; u < nunits; u += F.G) {
        const int m0 = (u / ntn) * 128, n0 = (u % ntn) * 64;
        float acc[4][4];
#pragma unroll
        for (int i = 0; i < 4; ++i)
#pragma unroll
            for (int j = 0; j < 4; ++j) acc[i][j] = 0.f;
        for (int k0 = 0; k0 < K; k0 += 32) {
            { const int row = tid >> 2, kc = (tid & 3) * 8; const v4u w = *(const GAS v4u*)(A + (size_t)(m0 + row) * lda + k0 + kc);
              As[(kc + 0) * 132 + row] = bflo(w.x); As[(kc + 1) * 132 + row] = bfhi(w.x); As[(kc + 2) * 132 + row] = bflo(w.y); As[(kc + 3) * 132 + row] = bfhi(w.y);
              As[(kc + 4) * 132 + row] = bflo(w.z); As[(kc + 5) * 132 + row] = bfhi(w.z); As[(kc + 6) * 132 + row] = bflo(w.w); As[(kc + 7) * 132 + row] = bfhi(w.w); }
            if (tid < 256) { const int row = tid >> 2, kc = (tid & 3) * 8; const v4u w = *(const GAS v4u*)(Bt + (size_t)(n0 + row) * ldb + k0 + kc);
              Bs[(kc + 0) * 68 + row] = bflo(w.x); Bs[(kc + 1) * 68 + row] = bfhi(w.x); Bs[(kc + 2) * 68 + row] = bflo(w.y); Bs[(kc + 3) * 68 + row] = bfhi(w.y);
              Bs[(kc + 4) * 68 + row] = bflo(w.z); Bs[(kc + 5) * 68 + row] = bfhi(w.z); Bs[(kc + 6) * 68 + row] = bflo(w.w); Bs[(kc + 7) * 68 + row] = bfhi(w.w); }
            __syncthreads();
#pragma unroll 8
            for (int kk = 0; kk < 32; ++kk) {
                const f32x4 av = *(const LAS f32x4*)(As + kk * 132 + ty * 4), bv = *(const LAS f32x4*)(Bs + kk * 68 + tx * 4);
#pragma unroll
                for (int i = 0; i < 4; ++i)
#pragma unroll
                    for (int j = 0; j < 4; ++j) acc[i][j] = fmaf(av[i], bv[j], acc[i][j]);
            }
            __syncthreads();
        }
#pragma unroll
        for (int i = 0; i < 4; ++i)
#pragma unroll
            for (int j = 0; j < 4; ++j) epi(m0 + ty * 4 + i, n0 + tx * 4 + j, acc[i][j]);
    }
}

__device__ __forceinline__ void p1_inproj_naive(Frame& F, int l) {
    const bf16* xb = (const bf16*)(F.dout + DO_XB); const bf16* W = (const bf16*)(F.ws + WS_WIN) + (size_t)l * NP * DM;
    bf16* proj = (bf16*)(F.ws + WS_PROJ); float* tmp = (float*)(F.dout + DO_TMP); const float* ssq = (const float*)(F.ws + WS_SSQ);
    auto epi = [&](int r, int c, float v) {
        const float s = (ssq[r] + ssq[T + r]) + (ssq[2 * T + r] + ssq[3 * T + r]);
        const float rs = 1.0f / sqrtf(s * (1.0f / DM) + NORM_EPS);
        v *= rs;
        if (c < PC_QA) proj[(size_t)r * NP + c] = (bf16)f2bf(v); else tmp[(size_t)r * 512 + (c - PC_QA)] = v;
    };
    naive_gemm(F, xb, DM, W, DM, T, NP, DM, epi);
}
__device__ __forceinline__ void p1b_post_naive(Frame& F, const Args& a, int l) {
    const float* tmp = (const float*)(F.dout + DO_TMP); bf16* proj = (bf16*)(F.ws + WS_PROJ); float* dtb = (float*)(F.ws + WS_DT); const float* cs = (const float*)(F.ws + WS_CS);
    const int gw = F.bid * NWAVES + F.wave, NGW = F.G * NWAVES, lane = F.lane;
    for (int r = gw; r < T; r += NGW) {
        const float* tr = tmp + (size_t)r * 512; bf16* pr = proj + (size_t)r * NP;
        float q[4]; float s = 0.f;
#pragma unroll
        for (int j = 0; j < 4; ++j) { q[j] = tr[lane + 64 * j]; s += q[j] * q[j]; }
        s = wave_sum(s); const float rq = 1.0f / sqrtf(s * (1.0f / 256.f) + NORM_EPS);
#pragma unroll
        for (int j = 0; j < 4; ++j) pr[PC_QA + lane + 64 * j] = (bf16)f2bf(q[j] * rq);
        float k0 = tr[256 + lane], k1 = tr[256 + 64 + lane]; float s2 = wave_sum(k0 * k0 + k1 * k1); const float rk = 1.0f / sqrtf(s2 * (1.0f / 128.f) + NORM_EPS);
        pr[PC_KV + lane] = (bf16)f2bf(k0 * rk); pr[PC_KV + 64 + lane] = (bf16)f2bf(k1 * rk);
        if (lane < 16) { const float t1 = tr[384 + lane], t2 = tr[384 + 16 + lane], c = cs[(size_t)r * 32 + lane], sn = cs[(size_t)r * 32 + 16 + lane];
            pr[PC_KR + lane] = (bf16)f2bf(t1 * c - t2 * sn); pr[PC_KR + 16 + lane] = (bf16)f2bf(t2 * c + t1 * sn); }
        if (lane < 8) dtb[(size_t)r * 8 + lane] = lane < 6 ? softplus_f(tr[416 + lane] + a.ssd_dt_bias[l * 6 + lane]) : 0.f;
        pr[PC_DT + lane] = 0; if (lane < 32) pr[PC_DT + 64 + lane] = 0;
    }
}
__device__ __forceinline__ void p2_qkv_naive(Frame& F, int l) {
    const bf16* proj = (const bf16*)(F.ws + WS_PROJ); const bf16* W = (const bf16*)(F.ws + WS_WQKV) + (size_t)l * NQKV * 256;
    bf16* qkv = (bf16*)(F.dout + DO_QKV); const float* cs = (const float*)(F.ws + WS_CS);
    const size_t total = (size_t)T * NQKV;
    for (size_t e = (size_t)F.bid * NTHR + F.tid; e < total; e += (size_t)F.G * NTHR) {
        const int r = (int)(e / NQKV), c = (int)(e % NQKV);
        const bool isq = c < 768; const bf16* ar = proj + (size_t)r * NP + (isq ? PC_QA : PC_KV);
        int c2 = -1; bool first = true;
        if (c >= QC_QR && c < QC_QR + 192) { const int i = (c - QC_QR) & 31; first = i < 16; c2 = first ? c + 16 : c - 16; }
        float d0 = 0.f, d1 = 0.f; const bf16* w0 = W + (size_t)c * 256; const bf16* w1 = W + (size_t)(c2 < 0 ? c : c2) * 256;
        for (int k = 0; k < 256; k += 8) { const v4u av = *(const GAS v4u*)(ar + k), b0 = *(const GAS v4u*)(w0 + k), b1 = *(const GAS v4u*)(w1 + k);
            d0 += bflo(av.x) * bflo(b0.x) + bfhi(av.x) * bfhi(b0.x) + bflo(av.y) * bflo(b0.y) + bfhi(av.y) * bfhi(b0.y) + bflo(av.z) * bflo(b0.z) + bfhi(av.z) * bfhi(b0.z) + bflo(av.w) * bflo(b0.w) + bfhi(av.w) * bfhi(b0.w);
            d1 += bflo(av.x) * bflo(b1.x) + bfhi(av.x) * bfhi(b1.x) + bflo(av.y) * bflo(b1.y) + bfhi(av.y) * bfhi(b1.y) + bflo(av.z) * bflo(b1.z) + bfhi(av.z) * bfhi(b1.z) + bflo(av.w) * bflo(b1.w) + bfhi(av.w) * bfhi(b1.w); }
        float v = d0;
        if (c2 >= 0) { const int i = (c - QC_QR) & 15; const float cc = cs[(size_t)r * 32 + i], sn = cs[(size_t)r * 32 + 16 + i];
            v = first ? d0 * cc - d1 * sn : d0 * cc + d1 * sn; }
        qkv[(size_t)r * NQKV + c] = (bf16)f2bf(v);
    }
}
__device__ __forceinline__ void p2_conva(Frame& F, const Args& a, int l) {
    const bf16* proj = (const bf16*)(F.ws + WS_PROJ); bf16* y = (bf16*)(F.ws + WS_Y); const float* cw = a.conv_a_w + (size_t)l * 3 * 256;
    const size_t total = (size_t)T * 256;
    for (size_t e = (size_t)F.bid * NTHR + F.tid; e < total; e += (size_t)F.G * NTHR) {
        const int r = (int)(e >> 8), c = (int)(e & 255), s = r % SEQ;
        float conv = 0.f;
#pragma unroll
        for (int k = 0; k < 3; ++k) { const int ds = s - 2 + k; if (ds >= 0) { const bf16* pr = proj + (size_t)(r - 2 + k) * NP; conv += cw[k * 256 + c] * (bf2f(pr[PC_AC + c]) * bf2f(pr[PC_AH + c])); } }
        const bf16* pr = proj + (size_t)r * NP;
        y[(size_t)r * DM + YC_A + c] = (bf16)f2bf(bf2f(pr[PC_AB + c]) * conv * silu_f(bf2f(pr[PC_AZ + c])));
    }
}
__device__ __forceinline__ void p3_attn_naive(Frame& F) {
    const bf16* qkv = (const bf16*)(F.dout + DO_QKV); const bf16* proj = (const bf16*)(F.ws + WS_PROJ); bf16* y = (bf16*)(F.ws + WS_Y);
    const int total = BATCH * NHEAD * SEQ;
    for (int e = F.bid * NTHR + F.tid; e < total; e += F.G * NTHR) {
        const int q = e % SEQ, h = (e / SEQ) % NHEAD, b = e / (SEQ * NHEAD); const size_t r = (size_t)b * SEQ + q;
        unsigned qp[48]; float o[64];
#pragma unroll
        for (int d = 0; d < 32; ++d) qp[d] = *(const GAS unsigned*)(qkv + r * NQKV + QC_QN + h * 64 + 2 * d);
#pragma unroll
        for (int d = 0; d < 16; ++d) qp[32 + d] = *(const GAS unsigned*)(qkv + r * NQKV + QC_QR + h * 32 + 2 * d);
#pragma unroll
        for (int d = 0; d < 64; ++d) o[d] = 0.f;
        float m = -INFINITY, lsum = 0.f;
        for (int j = 0; j <= q; ++j) {
            const size_t rj = (size_t)b * SEQ + j; const bf16* kn = qkv + rj * NQKV + QC_KN + h * 64; const bf16* kr = proj + rj * NP + PC_KR; const bf16* vv = qkv + rj * NQKV + QC_V + h * 64;
            float s = 0.f;
#pragma unroll
            for (int d = 0; d < 32; ++d) { const unsigned w = *(const GAS unsigned*)(kn + 2 * d); s += bflo(qp[d]) * bflo(w) + bfhi(qp[d]) * bfhi(w); }
#pragma unroll
            for (int d = 0; d < 16; ++d) { const unsigned w = *(const GAS unsigned*)(kr + 2 * d); s += bflo(qp[32 + d]) * bflo(w) + bfhi(qp[32 + d]) * bfhi(w); }
            const float mn = fmaxf(m, s), f = exp2f(m - mn), p = exp2f(s - mn);
            lsum = lsum * f + p; m = mn;
#pragma unroll
            for (int d = 0; d < 64; d += 2) { const unsigned w = *(const GAS unsigned*)(vv + d); o[d] = o[d] * f + p * bflo(w); o[d + 1] = o[d + 1] * f + p * bfhi(w); }
        }
        const float inv = 1.f / lsum; const bf16* cz = proj + r * NP + PC_CZ + h * 64;
#pragma unroll
        for (int d = 0; d < 64; ++d) y[r * DM + YC_C + h * 64 + d] = (bf16)f2bf(o[d] * inv * silu_f(bf2f(cz[d])));
    }
}
__device__ __forceinline__ void p3_ssd_naive(Frame& F, const Args& a, int l) {
    const bf16* proj = (const bf16*)(F.ws + WS_PROJ); const float* dtb = (const float*)(F.ws + WS_DT); float* ys = (float*)(F.ws + WS_ST);
    const float* cw = a.ssd_conv_w + (size_t)l * 4 * 896; const float* cb = a.ssd_conv_b + (size_t)l * 896;
    LAS float* bc = (LAS float*)F.lds;
    const int tid = F.tid;
    for (int u = F.bid; u < BATCH * SSD_G; u += F.G) {
        const int b = u / SSD_G, g = u % SSD_G;
        const int hh = tid / 64, p = tid % 64, h = g * 3 + hh;
        float st[128];
#pragma unroll
        for (int n = 0; n < 128; ++n) st[n] = 0.f;
        const float A = tid < 192 ? -__expf(a.ssd_a_log[l * 6 + h]) : 0.f, Dk = tid < 192 ? a.ssd_d[l * 6 + h] : 0.f;
        const int xc = hh * 64 + p + g * 192;
        for (int s = 0; s < SEQ; ++s) {
            const size_t r = (size_t)b * SEQ + s;
            if (tid < 256) {
                const int ch = tid < 128 ? 384 + g * 128 + tid : 640 + g * 128 + (tid - 128);
                const int pc = tid < 128 ? PC_SB + g * 128 + tid : PC_SC + g * 128 + (tid - 128);
                float v = cb[ch];
#pragma unroll
                for (int k = 0; k < 4; ++k) { const int ds = s - 3 + k; if (ds >= 0) v += cw[k * 896 + ch] * bf2f(proj[(r - 3 + k) * NP + pc]); }
                bc[tid] = silu_f(v);
            }
            __syncthreads();
            if (tid < 192) {
                float xv = cb[xc];
#pragma unroll
                for (int k = 0; k < 4; ++k) { const int ds = s - 3 + k; if (ds >= 0) xv += cw[k * 896 + xc] * bf2f(proj[(r - 3 + k) * NP + PC_SX + xc]); }
                xv = silu_f(xv);
                const float dt = dtb[r * 8 + h], dec = __expf(dt * A), xd = xv * dt;
                float yv = 0.f;
#pragma unroll
                for (int n = 0; n < 128; ++n) { st[n] = st[n] * dec + xd * bc[n]; yv += st[n] * bc[128 + n]; }
                ys[r * 384 + xc] = yv + xv * Dk;
            }
            __syncthreads();
        }
    }
}
__device__ __forceinline__ void p3b_ssd_gate_naive(Frame& F, const Args& a, int l) {
    const bf16* proj = (const bf16*)(F.ws + WS_PROJ); const float* ys = (const float*)(F.ws + WS_ST); bf16* y = (bf16*)(F.ws + WS_Y);
    const float* ng = a.ssd_norm_g + (size_t)l * 384;
    const int gw = F.bid * NWAVES + F.wave, NGW = F.G * NWAVES, lane = F.lane;
    for (int e = gw; e < T * 2; e += NGW) {
        const int r = e >> 1, g = e & 1; float v[3]; float s = 0.f;
#pragma unroll
        for (int j = 0; j < 3; ++j) { const int c = g * 192 + lane + 64 * j; v[j] = ys[(size_t)r * 384 + c] * silu_f(bf2f(proj[(size_t)r * NP + PC_SZ + c])); s += v[j] * v[j]; }
        s = wave_sum(s); const float rn = 1.0f / sqrtf(s * (1.0f / 192.f) + SSD_NORM_EPS);
#pragma unroll
        for (int j = 0; j < 3; ++j) { const int c = g * 192 + lane + 64 * j; y[(size_t)r * DM + YC_B + c] = (bf16)f2bf(v[j] * rn * ng[c]); }
    }
}
__device__ __forceinline__ void p4_outproj_naive(Frame& F, const Args& a, int l) {
    const bf16* y = (const bf16*)(F.ws + WS_Y); const bf16* W = (const bf16*)(F.ws + WS_WOUT) + (size_t)l * DM * DM;
    const float* base = l == 0 ? a.x : (const float*)(F.ws + WS_XRES); float* xo = l == 0 ? (float*)(F.ws + WS_XRES) : a.out;
    auto epi = [&](int r, int c, float v) { xo[(size_t)r * DM + c] = base[(size_t)r * DM + c] + v; };
    naive_gemm(F, y, DM, W, DM, T, DM, DM, epi);
}
__device__ __forceinline__ void p4b_stats_naive(Frame& F, const Args& a, int l) {
    const float* xo = l == 0 ? (const float*)(F.ws + WS_XRES) : a.out; bf16* xb = (bf16*)(F.dout + DO_XB); float* ssq = (float*)(F.ws + WS_SSQ);
    const int gw = F.bid * NWAVES + F.wave, NGW = F.G * NWAVES;
    for (int m = gw; m < T; m += NGW) {
        const GAS f32x4* xr = (const GAS f32x4*)(xo + (size_t)m * DM) + F.lane; GAS v2u* o8 = (GAS v2u*)(xb + (size_t)m * DM) + F.lane;
        float s = 0.f;
#pragma unroll
        for (int j = 0; j < 4; ++j) { const f32x4 v = xr[64 * j]; s += (v.x * v.x + v.y * v.y) + (v.z * v.z + v.w * v.w);
            if (l == 0) { v2u w; w.x = pk2(v.x, v.y); w.y = pk2(v.z, v.w); o8[64 * j] = w; } }
        s = wave_sum(s);
        if (F.lane < 4) ssq[F.lane * T + m] = F.lane == 0 ? s : 0.f;
    }
}
__device__ __forceinline__ void p5_final(Frame& F, const Args& a) {
    const float* ssq = (const float*)(F.ws + WS_SSQ);
    const int gw = F.bid * NWAVES + F.wave, NGW = F.G * NWAVES;
    for (int m = gw; m < T; m += NGW) {
        GAS f32x4* xr = (GAS f32x4*)(a.out + (size_t)m * DM) + F.lane; const GAS f32x4* gr = (const GAS f32x4*)a.final_norm_g + F.lane;
        const float s = (ssq[m] + ssq[T + m]) + (ssq[2 * T + m] + ssq[3 * T + m]); const float rs = 1.0f / sqrtf(s * (1.0f / DM) + NORM_EPS);
#pragma unroll
        for (int j = 0; j < 4; ++j) { const f32x4 v = xr[64 * j], g = gr[64 * j]; xr[64 * j] = v * rs * g; }
    }
}

constexpr int PH_PER_LAYER = 7, N_PHASES = 1 + DEPTH * PH_PER_LAYER + 1;
__global__ void __launch_bounds__(NTHR, 2) fwd_kernel(Args args) {
    extern __shared__ __attribute__((aligned(16))) unsigned char lds[];
    Frame F;
    F.lds = (LAS unsigned char*)lds; F.tid = threadIdx.x; F.lane = F.tid & 63; F.wave = __builtin_amdgcn_readfirstlane(F.tid >> 6);
    F.G = gridDim.x; F.bid = blockIdx.x; F.ws = args.ws; F.dout = (unsigned char*)args.out;
    volatile LAS unsigned* MISC = (volatile LAS unsigned*)(F.lds + MISC_OFF);
    if (F.tid < 32) MISC[F.tid] = 0u;
    __syncthreads();
    gu32* ctl = (gu32*)(F.ws + WS_CTL);
    XcdBarrier bar; bar.bar = (unsigned*)(ctl + CW_BAR); bar.x = 0; bar.st = nullptr;
    const bool multi = (args.ph_hi - args.ph_lo) > 1;
    if (multi) bar = xcd_barrier_post((unsigned*)(ctl + CW_BAR), MISC + 8);
    const int lo = args.ph_lo, hi = args.ph_hi;
#define IN(k) (lo <= (k) && (k) < hi)
#define SEAM(k) do { if (IN(k) && IN((k) + 1)) xcd_barrier(bar); } while (0)
    if (IN(0)) { p0_prologue(F, args); } SEAM(0);
#define LAYER(l) do { constexpr int pb = 1 + (l) * PH_PER_LAYER; \
        if (IN(pb + 0)) { p1_inproj_naive(F, l); } SEAM(pb + 0); \
        if (IN(pb + 1)) { p1b_post_naive(F, args, l); } SEAM(pb + 1); \
        if (IN(pb + 2)) { p2_qkv_naive(F, l); p2_conva(F, args, l); } SEAM(pb + 2); \
        if (IN(pb + 3)) { p3_attn_naive(F); p3_ssd_naive(F, args, l); } SEAM(pb + 3); \
        if (IN(pb + 4)) { p3b_ssd_gate_naive(F, args, l); } SEAM(pb + 4); \
        if (IN(pb + 5)) { p4_outproj_naive(F, args, l); } SEAM(pb + 5); \
        if (IN(pb + 6)) { p4b_stats_naive(F, args, l); } SEAM(pb + 6); } while (0)
    LAYER(0);
    LAYER(1);
    static_assert(DEPTH == 2, "two layers written out");
#undef LAYER
    if (IN(N_PHASES - 1)) p5_final(F, args);
#undef IN
#undef SEAM
}

extern "C" void kernel_launch(void* const* d_in, const int* in_sizes, int n_in, void* d_out, int out_size, void* d_ws, size_t ws_size, hipStream_t stream) {
    static int grid = 0;
    if (grid == 0) {
        if (n_in != 17 || in_sizes[0] != T * DM || out_size != T * DM || ws_size < WS_END) { fprintf(stderr, "kernel_launch: unexpected shapes (n_in %d, in0 %d, out %d, ws %zu)\n", n_in, n_in > 0 ? in_sizes[0] : -1, out_size, ws_size); grid = -1; return; }
        int dev = 0, cus = 0;
        if (hipGetDevice(&dev) != hipSuccess || hipDeviceGetAttribute(&cus, hipDeviceAttributeMultiprocessorCount, dev) != hipSuccess) { grid = -1; return; }
        if (hipFuncSetAttribute((const void*)fwd_kernel, hipFuncAttributeMaxDynamicSharedMemorySize, LDS_BYTES) != hipSuccess) { fprintf(stderr, "kernel_launch: hipFuncSetAttribute failed\n"); grid = -1; return; }
        int per_cu = 0;
        if (hipOccupancyMaxActiveBlocksPerMultiprocessor(&per_cu, (const void*)fwd_kernel, NTHR, LDS_BYTES) != hipSuccess || per_cu < 1) fprintf(stderr, "kernel_launch: occupancy query reports %d\n", per_cu);
        (void)hipGetLastError();
        grid = cus;
    }
    if (grid < 0) return;
    (void)hipMemsetAsync((char*)d_ws + WS_CTL, 0, CTL_ZERO_BYTES, stream);
    Args a{};
    a.x = (const float*)d_in[0]; a.pos = (const int*)d_in[1]; a.norm_g = (const float*)d_in[2]; a.w_in = (const float*)d_in[3]; a.conv_a_w = (const float*)d_in[4];
    a.ssd_conv_w = (const float*)d_in[5]; a.ssd_conv_b = (const float*)d_in[6]; a.ssd_dt_bias = (const float*)d_in[7]; a.ssd_a_log = (const float*)d_in[8]; a.ssd_d = (const float*)d_in[9];
    a.ssd_norm_g = (const float*)d_in[10]; a.mla_q_norm_g = (const float*)d_in[11]; a.w_qb = (const float*)d_in[12]; a.mla_kv_norm_g = (const float*)d_in[13]; a.w_kvb = (const float*)d_in[14];
    a.w_out = (const float*)d_in[15]; a.final_norm_g = (const float*)d_in[16];
    a.out = (float*)d_out; a.ws = (unsigned char*)d_ws;
#if MK_N_LAUNCHES == 1
    a.ph_lo = 0; a.ph_hi = N_PHASES;
    hipLaunchKernelGGL(fwd_kernel, dim3(grid), dim3(NTHR), LDS_BYTES, stream, a);
#else
    for (int ph = 0; ph < N_PHASES; ++ph) { a.ph_lo = ph; a.ph_hi = ph + 1; hipLaunchKernelGGL(fwd_kernel, dim3(grid), dim3(NTHR), LDS_BYTES, stream, a); }
#endif
}
```

```cpp
#include <hip/hip_runtime.h>
#include <cstdio>
#include <cstdint>

#ifndef MK_N_LAUNCHES
#define MK_N_LAUNCHES 1
#endif

constexpr int BATCH = 8, SEQ = 2048, DM = 1024, DEPTH = 2, T = BATCH * SEQ;
constexpr int IN_COLS = 3110;
constexpr int NP = 3328;
constexpr int PC_AH = 0, PC_AB = 256, PC_AC = 512, PC_AZ = 768, PC_SZ = 1024, PC_SX = 1408, PC_SB = 1792, PC_SC = 2048,
              PC_CZ = 2304, PC_QA = 2816, PC_KV = 3072, PC_KR = 3200, PC_DT = 3232;
constexpr int NQKV = 1536;
constexpr int QC_QN = 0, QC_QR = 384, QC_KN = 768, QC_V = 1152;
constexpr int YC_A = 0, YC_B = 256, YC_C = 640;
constexpr int NHEAD = 6, SSD_H = 6, SSD_P = 64, SSD_N = 128, SSD_G = 2, CHUNK = 128, NCHUNK = SEQ / CHUNK;
constexpr float NORM_EPS = 1e-6f, SSD_NORM_EPS = 1e-5f;
constexpr float ATT_C2 = 0.10206207261596577f * 1.4426950408889634f;

constexpr size_t MiB = 1u << 20;
constexpr size_t WS_CTL = 0, CTL_ZERO_BYTES = 64 * 1024;
constexpr size_t WS_WIN = 1 * MiB;
constexpr size_t WS_WQKV = WS_WIN + (size_t)DEPTH * NP * DM * 2;
constexpr size_t WS_WOUT = WS_WQKV + (size_t)DEPTH * NQKV * 256 * 2;
constexpr size_t WS_CS = WS_WOUT + (size_t)DEPTH * DM * DM * 2;
constexpr size_t WS_DT = WS_CS + (size_t)T * 32 * 4;
constexpr size_t WS_SSQ = WS_DT + (size_t)T * 8 * 4;
constexpr size_t WS_CDEC = WS_SSQ + (size_t)4 * T * 4;
constexpr size_t WS_XRES = 24 * MiB;
constexpr size_t WS_PROJ = WS_XRES + (size_t)T * DM * 4;
constexpr size_t WS_Y = WS_PROJ + (size_t)T * NP * 2;
constexpr size_t WS_ST = WS_Y + (size_t)T * DM * 2;
constexpr size_t WS_END = WS_ST + (size_t)T * 384 * 4;
static_assert(WS_CDEC + (size_t)BATCH * NCHUNK * 8 * 4 <= WS_XRES, "ws map (small)");
static_assert(WS_END <= 256 * MiB, "ws map");
constexpr size_t DO_QKV = 0;
constexpr size_t DO_XB = 0;
constexpr size_t DO_TMP = 32 * MiB;

constexpr int CW_TMO = 0, CW_BAR = 1024, CW_Q = 8192;

constexpr int RING_BYTES = 131072, XCH_OFF = RING_BYTES, XCH_BYTES = 8192, MISC_OFF = XCH_OFF + XCH_BYTES, LDS_BYTES = 147456;
constexpr int NWAVES = 8, NTHR = NWAVES * 64;

#define GAS __attribute__((address_space(1)))
#define LAS __attribute__((address_space(3)))
typedef unsigned short bf16;
typedef unsigned v4u __attribute__((ext_vector_type(4)));
typedef unsigned v2u __attribute__((ext_vector_type(2)));
typedef float f32x4 __attribute__((ext_vector_type(4)));
typedef short bf16x8 __attribute__((ext_vector_type(8)));
typedef GAS unsigned gu32;
#define RLX_AGENT __ATOMIC_RELAXED, __HIP_MEMORY_SCOPE_AGENT
#define LDS_WAIT() asm volatile("s_waitcnt lgkmcnt(0)" ::: "memory")
#define VM_WAIT() asm volatile("s_waitcnt vmcnt(0)" ::: "memory")

__device__ __forceinline__ unsigned f2bf(float f) { unsigned u = __builtin_bit_cast(unsigned, f); return (u + 0x7fffu + ((u >> 16) & 1u)) >> 16; }
__device__ __forceinline__ unsigned pk2(float lo, float hi) { return f2bf(lo) | (f2bf(hi) << 16); }
__device__ __forceinline__ float bf2f(unsigned short b) { return __builtin_bit_cast(float, (unsigned)b << 16); }
__device__ __forceinline__ float bflo(unsigned w) { return __builtin_bit_cast(float, w << 16); }
__device__ __forceinline__ float bfhi(unsigned w) { return __builtin_bit_cast(float, w & 0xffff0000u); }
__device__ __forceinline__ float silu_f(float x) { return x / (1.f + __expf(-x)); }
__device__ __forceinline__ float softplus_f(float x) { return fmaxf(x, 0.f) + log1pf(__expf(-fabsf(x))); }

#define XB_TMO      128
#define XB_XCNT(j)  (256  + 64 * (j))
#define XB_XSUB(j)  (1280 + 64 * (j))
#define XB_XGEN(j)  (2304 + 64 * (j))
#define XB_TOP      3328
#define XB_TOPGEN   3392
#define XCD_BAR_WORDS 3456
#define XB_SPIN_CAP (1u << 22)
__device__ __forceinline__ unsigned xb_ld(unsigned* p)              { return __hip_atomic_load(p, __ATOMIC_RELAXED, __HIP_MEMORY_SCOPE_AGENT); }
__device__ __forceinline__ unsigned xb_add(unsigned* p, unsigned v) { return __hip_atomic_fetch_add(p, v, __ATOMIC_RELAXED, __HIP_MEMORY_SCOPE_AGENT); }
__device__ __forceinline__ unsigned xb_xcc_id() { return (unsigned)__builtin_amdgcn_s_getreg((3 << 11) | 20) & 0xFu; }
#define XB_SPIN(cond, bar) do { unsigned _sp = 0; while (cond) { __builtin_amdgcn_s_sleep(1); \
    if ((++_sp & 255u) == 0u) { if (xb_ld(&(bar)[XB_TMO])) break; if (_sp > XB_SPIN_CAP) { atomicAdd(&(bar)[XB_TMO], 1u); break; } } } } while (0)
struct XcdBarrier { unsigned* bar; unsigned x; volatile LAS unsigned* st; };
__device__ __forceinline__ XcdBarrier xcd_barrier_post(unsigned* bar, volatile LAS unsigned* st, bool leader) {
    XcdBarrier b; b.bar = bar; b.x = xb_xcc_id(); b.st = st;
    if (leader) (void)xb_add(&bar[XB_XCNT(b.x)], 1u);
    return b;
}
__device__ __forceinline__ void xcd_barrier_complete(unsigned* bar, unsigned x, unsigned& nloc, unsigned& nx) {
    const unsigned G = gridDim.x * gridDim.y * gridDim.z;
    unsigned sum, cnt, mine, sp = 0u;
    for (;;) {
        sum = 0u; cnt = 0u; mine = 0u;
#pragma unroll
        for (unsigned j = 0; j < 16; ++j) { const unsigned c = xb_ld(&bar[XB_XCNT(j)]); sum += c; cnt += (c > 0u) ? 1u : 0u; mine = (j == x) ? c : mine; }
        if (sum == G) break;
        __builtin_amdgcn_s_sleep(1);
        if ((++sp & 255u) == 0u) { if (xb_ld(&bar[XB_TMO])) break; if (sp > XB_SPIN_CAP) { atomicAdd(&bar[XB_TMO], 1u); break; } }
    }
    nloc = mine > 0u ? mine : 1u; nx = cnt > 0u ? cnt : 1u;
}
__device__ __forceinline__ void xcd_barrier(const XcdBarrier& b, bool leader) {
    asm volatile("s_waitcnt vmcnt(0)" ::: "memory");
    __syncthreads();
    if (leader) {
        unsigned* bar = b.bar;
        __builtin_amdgcn_s_waitcnt(0);
        unsigned nloc = b.st[0], nx = b.st[1];
        if (nloc == 0u) { xcd_barrier_complete(bar, b.x, nloc, nx); b.st[0] = nloc; b.st[1] = nx; }
        const unsigned old = xb_add(&bar[XB_XSUB(b.x)], 1u);
        const unsigned gen = old / nloc;
        if (old + 1u == (gen + 1u) * nloc) {
            __builtin_amdgcn_fence(__ATOMIC_RELEASE, "agent");
            asm volatile("s_waitcnt vmcnt(0)" ::: "memory");
            const unsigned og = xb_add(&bar[XB_TOP], 1u);
            const unsigned tg = og / nx;
            if (og + 1u == (tg + 1u) * nx) xb_add(&bar[XB_TOPGEN], 1u);
            else XB_SPIN(xb_ld(&bar[XB_TOPGEN]) == tg, bar);
            __builtin_amdgcn_fence(__ATOMIC_ACQUIRE, "agent");
            xb_add(&bar[XB_XGEN(b.x)], 1u);
            asm volatile("s_waitcnt vmcnt(0)" ::: "memory");
        } else {
            XB_SPIN(xb_ld(&bar[XB_XGEN(b.x)]) == gen, bar);
            __builtin_amdgcn_fence(__ATOMIC_ACQUIRE, "agent");
            asm volatile("s_waitcnt vmcnt(0)" ::: "memory");
        }
    }
    __syncthreads();
}

struct Args {
    const float* x; const int* pos; const float* norm_g; const float* w_in; const float* conv_a_w; const float* ssd_conv_w; const float* ssd_conv_b;
    const float* ssd_dt_bias; const float* ssd_a_log; const float* ssd_d; const float* ssd_norm_g; const float* mla_q_norm_g; const float* w_qb;
    const float* mla_kv_norm_g; const float* w_kvb; const float* w_out; const float* final_norm_g;
    float* out; unsigned char* ws; int ph_lo, ph_hi;
};
struct Frame {
    LAS unsigned char* lds; int wave, G, bid;
    unsigned char* ws; unsigned char* dout;
};
__device__ __forceinline__ int lane_id() { int l; asm volatile("v_mbcnt_lo_u32_b32 %0, -1, 0\n\tv_mbcnt_hi_u32_b32 %0, -1, %0" : "=v"(l)); return l; }
#define FRAME_IDS const int lane = lane_id(), tid = F.wave * 64 + lane; (void)tid; (void)lane
__device__ __forceinline__ float wave_sum(float v) {
#pragma unroll
    for (int o = 1; o < 64; o <<= 1) v += __shfl_xor(v, o);
    return v;
}

__device__ __forceinline__ int win_src_col(int n) {
    if (n < 2304) return n;
    if (n < 2688) return 2726 + (n - 2304);
    if (n < 2816) return -1;
    if (n < 3072) return 2310 + (n - 2816);
    if (n < 3200) return 2566 + (n - 3072);
    if (n < 3232) return 2694 + (n - 3200);
    if (n < 3238) return 2304 + (n - 3232);
    return -1;
}
__device__ __forceinline__ int wqkv_src_col(int n, int& which) {
    if (n < 384) { which = 0; return (n >> 6) * 96 + (n & 63); }
    if (n < 576) { which = 0; const int r = n - 384; return (r >> 5) * 96 + 64 + (r & 31); }
    if (n < 768) { which = -1; return -1; }
    if (n < 1152) { which = 1; const int r = n - 768; return (r >> 6) * 128 + (r & 63); }
    which = 1; const int r = n - 1152; return (r >> 6) * 128 + 64 + (r & 63);
}

template <class SrcFn>
__device__ __forceinline__ void transpose_item(const SrcFn& src, int K, bf16* WT, LAS float* scr, int kb, int nb, int lane) {
    const int k0 = 64 * kb, n0 = 32 * nb;
#pragma unroll 8
    for (int i = 0; i < 32; ++i) { const int kk = 2 * i + (lane >> 5); scr[kk * 33 + (lane & 31)] = src(k0 + kk, n0 + (lane & 31)); }
    LDS_WAIT(); asm volatile("" ::: "memory");
    const int c = lane & 7;
#pragma unroll
    for (int j = 0; j < 4; ++j) { const int n = (lane >> 3) + 8 * j; const LAS float* s = scr + (8 * c) * 33 + n;
        v4u o; o.x = pk2(s[0 * 33], s[1 * 33]); o.y = pk2(s[2 * 33], s[3 * 33]); o.z = pk2(s[4 * 33], s[5 * 33]); o.w = pk2(s[6 * 33], s[7 * 33]);
        *(GAS v4u*)(WT + (size_t)(n0 + n) * K + k0 + 8 * c) = o; }
    LDS_WAIT(); asm volatile("" ::: "memory");
}
__device__ __forceinline__ void p0_prologue(Frame& F, const Args& a) {
    FRAME_IDS;
    LAS float* scr = (LAS float*)(F.lds + F.wave * 16384);
    const int gw = F.bid * NWAVES + F.wave, NGW = F.G * NWAVES;
    bf16* Win_t = (bf16*)(F.ws + WS_WIN); bf16* Wqkv_t = (bf16*)(F.ws + WS_WQKV); bf16* Wout_t = (bf16*)(F.ws + WS_WOUT);
    constexpr int I_IN = (DM / 64) * (NP / 32), I_QKV = (256 / 64) * (NQKV / 32), I_OUT = (DM / 64) * (DM / 32), I_L = I_IN + I_QKV + I_OUT;
    for (int it = gw; it < DEPTH * I_L; it += NGW) {
        const int l = it / I_L; int r = it % I_L;
        if (r < I_IN) {
            const float* W = a.w_in + (size_t)l * DM * IN_COLS; const float* g = a.norm_g + l * DM;
            auto src = [&](int k, int n) -> float { const int sc = win_src_col(n); return sc < 0 ? 0.f : W[(size_t)k * IN_COLS + sc] * g[k]; };
            transpose_item(src, DM, Win_t + (size_t)l * NP * DM, scr, r / (NP / 32), r % (NP / 32), lane); continue; }
        r -= I_IN;
        if (r < I_QKV) {
            const float* Wq = a.w_qb + (size_t)l * 256 * 576; const float* Wkv = a.w_kvb + (size_t)l * 128 * 768;
            const float* gq = a.mla_q_norm_g + l * 256; const float* gkv = a.mla_kv_norm_g + l * 128;
            auto src = [&](int k, int n) -> float { int which; const int sc = wqkv_src_col(n, which);
                if (which == 0) return Wq[(size_t)k * 576 + sc] * gq[k] * ATT_C2;
                if (which == 1) return k < 128 ? Wkv[(size_t)k * 768 + sc] * gkv[k] : 0.f;
                return 0.f; };
            transpose_item(src, 256, Wqkv_t + (size_t)l * NQKV * 256, scr, r / (NQKV / 32), r % (NQKV / 32), lane); continue; }
        r -= I_QKV;
        { const float* W = a.w_out + (size_t)l * DM * DM;
          auto src = [&](int k, int n) -> float { return W[(size_t)k * DM + n]; };
          transpose_item(src, DM, Wout_t + (size_t)l * DM * DM, scr, r / (DM / 32), r % (DM / 32), lane); }
    }
    bf16* xb = (bf16*)(F.dout + DO_XB); float* ssq = (float*)(F.ws + WS_SSQ);
    for (int m = gw; m < T; m += NGW) {
        const GAS f32x4* xr = (const GAS f32x4*)(a.x + (size_t)m * DM) + lane; GAS v2u* o8 = (GAS v2u*)(xb + (size_t)m * DM) + lane;
        float s = 0.f;
#pragma unroll
        for (int j = 0; j < 4; ++j) { const f32x4 v = xr[64 * j]; s += (v.x * v.x + v.y * v.y) + (v.z * v.z + v.w * v.w); v2u w; w.x = pk2(v.x, v.y); w.y = pk2(v.z, v.w); o8[64 * j] = w; }
        s = wave_sum(s);
        if (lane < 4) ssq[lane * T + m] = lane == 0 ? s : 0.f;
    }
    float* cs = (float*)(F.ws + WS_CS);
    for (int i = F.bid * NTHR + tid; i < T * 16; i += F.G * NTHR) {
        const int t = i >> 4, j = i & 15;
        const float inv = (float)pow(10000.0, -(double)(2 * j) / 32.0);
        const float ang = (float)a.pos[t] * inv;
        cs[(size_t)t * 32 + j] = cosf(ang); cs[(size_t)t * 32 + 16 + j] = sinf(ang);
    }
}


namespace pg8 {
#define PG8_LAS __attribute__((address_space(3)))
typedef unsigned short bf16_t;
typedef short bf16x8 __attribute__((ext_vector_type(8)));
typedef float f32x4 __attribute__((ext_vector_type(4)));
typedef unsigned u32x4 __attribute__((ext_vector_type(4)));
typedef unsigned u32x2 __attribute__((ext_vector_type(2)));
constexpr int BM = 256, BK = 64, HALF = 128, HTB = HALF * BK * 2, STAGE_BYTES = 8 * HTB, NXCD = 8, WGM = 8;
__host__ __device__ __forceinline__ int lds_byte(int r, int c) { const int st = (r >> 4) * 2 + (c >> 5), rr = r & 15, cc = c & 31, ob = rr * 64 + cc * 2; return st * 1024 + (ob ^ (((ob >> 9) & 1) << 5)); }
__host__ __device__ __forceinline__ void stage_rc(int b, int& R, int& C) { const int st = b / 1024, sb = b % 1024, swz = sb ^ (((sb >> 9) & 1) << 5); R = (st >> 1) * 16 + swz / 64; C = (st & 1) * 32 + (swz % 64) / 2; }
__host__ __device__ __forceinline__ int perm32(int rho) { const int n = rho >> 4, i = rho & 15; return 8 * (i >> 2) + 4 * n + (i & 3); }
struct Unit { int pm, pn; };
struct Gemm { const bf16_t* A; const bf16_t* Bt; int lda, ldb, K; int acol_lo, acol_hi, pn_split; };
struct StaticOrder {
    int nM, nN, nwg, G, c;
    __host__ __device__ void init(int M, int N, int G_, int c_) { nM = M / BM; nN = N / BM; nwg = nM * nN; G = G_; c = c_; }
    __host__ __device__ bool next(int i, Unit& u) const {
        const long L = (long)i * G + c; if (L >= nwg) return false;
        int wgid = (int)L; { const int q = nwg / NXCD, r = nwg % NXCD, xcd = wgid % NXCD, off = wgid / NXCD; wgid = (xcd < r ? xcd * (q + 1) : r * (q + 1) + (xcd - r) * q) + off; }
        const int nig = WGM * nN, gid = wgid / nig, fm = gid * WGM, gsz = (nM - fm) < WGM ? (nM - fm) : WGM;
        u.pm = fm + ((wgid % nig) % gsz); u.pn = (wgid % nig) / gsz; return true;
    }
    __device__ __forceinline__ void a_ready(const Unit&) const {}
    __device__ __forceinline__ void done(const Unit&) const {}
};
__device__ __forceinline__ unsigned cvt_pk_bf16(float lo, float hi) { unsigned r; asm volatile("v_cvt_pk_bf16_f32 %0, %1, %2" : "=v"(r) : "v"(lo), "v"(hi)); return r; }

template <class Epi, class Sched, bool ALIGN_EPI = false, bool SP2 = false>
__device__ __forceinline__ void gemm_phase(PG8_LAS unsigned char* lds, const Gemm g, const Sched& S, const Epi& E, int wid, int lane) {
    const int tid = wid * 64 + lane, wr = wid >> 2, wc = wid & 3, fr = lane & 15, fq = lane >> 4;
    const int K = g.K, nt = K / BK;
    unsigned voffA[2], voffB[2];
#pragma unroll
    for (int i = 0; i < 2; ++i) { int R, C; stage_rc(tid * 16 + i * 8192, R, C); const int Rb = Epi::PERM ? ((R & ~31) + perm32(R & 31)) : R;
        voffA[i] = (unsigned)(R * g.lda + C) * 2u; voffB[i] = (unsigned)(Rb * g.ldb + C) * 2u; }
    const size_t kstep = (size_t)(BK * 2);
    const size_t hstepA = (size_t)HALF * g.lda * 2, hstepB = (size_t)HALF * g.ldb * 2;
    const size_t tstepA = 2 * hstepA, tstepB = 2 * hstepB;
    const unsigned ldsw = (unsigned)wid * 1024u;
    const int aoff = lds_byte(wr * 64 + fr, fq * 8), boff = lds_byte(wc * 32 + fr, fq * 8);
#define PG8_SA(b, h) (((b) * 2 + (h)) * HTB)
#define PG8_SB(b, h) ((4 + (b) * 2 + (h)) * HTB)
#define PG8_STAGE(bufoff, gbase, voff) do { _Pragma("unroll") for (int _i = 0; _i < 2; ++_i) \
        __builtin_amdgcn_global_load_lds((const unsigned*)((const char*)(gbase) + (voff)[_i]), (PG8_LAS unsigned*)(lds + (bufoff) + ldsw + _i * 8192), 16, 0, 0); } while (0)
#define PG8_LDA(dst, b, h) do { _Pragma("unroll") for (int m = 0; m < 4; ++m) _Pragma("unroll") for (int k = 0; k < 2; ++k) dst[m][k] = *(const PG8_LAS bf16x8*)(lds + PG8_SA(b, h) + aoff + m * 2048 + k * 1024); } while (0)
#define PG8_LDB(dst, b, h) do { _Pragma("unroll") for (int n = 0; n < 2; ++n) _Pragma("unroll") for (int k = 0; k < 2; ++k) dst[n][k] = *(const PG8_LAS bf16x8*)(lds + PG8_SB(b, h) + boff + n * 2048 + k * 1024); } while (0)
#define PG8_MMA(ai, bj, At, Bt) do { __builtin_amdgcn_s_setprio(1); _Pragma("unroll") for (int m = 0; m < 4; ++m) _Pragma("unroll") for (int n = 0; n < 2; ++n) _Pragma("unroll") for (int k = 0; k < 2; ++k) \
        acc[ai][bj][m][n] = __builtin_amdgcn_mfma_f32_16x16x32_bf16(Bt[n][k], At[m][k], acc[ai][bj][m][n], 0, 0, 0); __builtin_amdgcn_s_setprio(0); } while (0)
#define PG8_WAIT_V(n) asm volatile("s_waitcnt vmcnt(" #n ")" ::: "memory")
#define PG8_WAIT_L(n) asm volatile("s_waitcnt lgkmcnt(" #n ")" ::: "memory")
#define PG8_BAR __builtin_amdgcn_s_barrier()
#define PG8_SCHED __builtin_amdgcn_sched_barrier(0)
#define PG8_ACOL(u) ((size_t)(((u).pn < g.pn_split) ? g.acol_lo : g.acol_hi) * 2)
    Unit cur, nxt; int ui = 0;
    if (!S.next(0, cur)) return;
    f32x4 acc[2][2][4][2];
#pragma unroll
    for (int a = 0; a < 2; ++a)
#pragma unroll
        for (int b = 0; b < 2; ++b)
#pragma unroll
            for (int m = 0; m < 4; ++m)
#pragma unroll
                for (int n = 0; n < 2; ++n) acc[a][b][m][n] = (f32x4){0.f, 0.f, 0.f, 0.f};
    bf16x8 At[4][2], B0[2][2], B1[2][2];
    const char* cA = (const char*)g.A + (size_t)cur.pm * tstepA + PG8_ACOL(cur); const char* cB = (const char*)g.Bt + (size_t)cur.pn * tstepB;
    S.a_ready(cur);
    if constexpr (SP2) {
        PG8_STAGE(PG8_SB(0, 0), cB, voffB); PG8_STAGE(PG8_SB(0, 1), cB + hstepB, voffB); PG8_STAGE(PG8_SA(0, 0), cA, voffA); PG8_STAGE(PG8_SA(0, 1), cA + hstepA, voffA);
        if (wr == 1) PG8_BAR;
        PG8_WAIT_V(2); PG8_BAR;
        PG8_STAGE(PG8_SB(1, 0), cB + kstep, voffB); PG8_STAGE(PG8_SA(1, 0), cA + kstep, voffA); PG8_STAGE(PG8_SB(1, 1), cB + hstepB + kstep, voffB);
        PG8_WAIT_V(6); PG8_BAR;
    } else {
        PG8_STAGE(PG8_SB(0, 0), cB, voffB); PG8_STAGE(PG8_SA(0, 0), cA, voffA); PG8_STAGE(PG8_SB(0, 1), cB + hstepB, voffB); PG8_STAGE(PG8_SA(0, 1), cA + hstepA, voffA);
        if (wr == 1) PG8_BAR;
        PG8_WAIT_V(4); PG8_BAR;
        PG8_STAGE(PG8_SB(1, 0), cB + kstep, voffB); PG8_STAGE(PG8_SA(1, 0), cA + kstep, voffA); PG8_STAGE(PG8_SB(1, 1), cB + hstepB + kstep, voffB);
        PG8_WAIT_V(6); PG8_BAR;
    }
    for (;;) {
        const bool has_next = S.next(ui + 1, nxt);
        const char* nA = has_next ? (const char*)g.A + (size_t)nxt.pm * tstepA + PG8_ACOL(nxt) : cA; const char* nB = has_next ? (const char*)g.Bt + (size_t)nxt.pn * tstepB : cB;
        for (int t = 0; t < nt; t += 2) {
            const bool last = (t == nt - 2);
            const char* a1 = cA + (size_t)(t + 1) * kstep;
            const char* a2 = last ? nA : cA + (size_t)(t + 2) * kstep; const char* b2 = last ? nB : cB + (size_t)(t + 2) * kstep;
            const char* a3 = a2 + kstep; const char* b3 = b2 + kstep;
            if (last && has_next) S.a_ready(nxt);
            if constexpr (SP2) {
            PG8_LDB(B0, 0, 0); PG8_LDB(B1, 0, 1); PG8_SCHED; PG8_LDA(At, 0, 0); PG8_STAGE(PG8_SA(1, 1), a1 + hstepA, voffA);
            PG8_WAIT_V(8); PG8_WAIT_L(0); PG8_BAR; PG8_MMA(0, 0, At, B0); PG8_MMA(0, 1, At, B1); PG8_BAR; PG8_SCHED;
            PG8_LDA(At, 0, 1); PG8_STAGE(PG8_SB(0, 0), b2, voffB); PG8_STAGE(PG8_SB(0, 1), b2 + hstepB, voffB); PG8_STAGE(PG8_SA(0, 0), a2, voffA);
            PG8_WAIT_V(8); PG8_WAIT_L(0); PG8_BAR; PG8_MMA(1, 0, At, B0); PG8_MMA(1, 1, At, B1); PG8_BAR; PG8_SCHED;
            PG8_LDB(B0, 1, 0); PG8_LDB(B1, 1, 1); PG8_SCHED; PG8_LDA(At, 1, 0); PG8_STAGE(PG8_SA(0, 1), a2 + hstepA, voffA);
            PG8_WAIT_V(8); PG8_WAIT_L(0); PG8_BAR; PG8_MMA(0, 0, At, B0); PG8_MMA(0, 1, At, B1); PG8_BAR; PG8_SCHED;
            PG8_LDA(At, 1, 1); PG8_STAGE(PG8_SB(1, 0), b3, voffB); PG8_STAGE(PG8_SB(1, 1), b3 + hstepB, voffB); PG8_STAGE(PG8_SA(1, 0), a3, voffA);
            PG8_WAIT_V(8); PG8_WAIT_L(0); PG8_BAR; PG8_MMA(1, 0, At, B0); PG8_MMA(1, 1, At, B1); PG8_BAR; PG8_SCHED;
            } else {
            PG8_LDB(B0, 0, 0); PG8_SCHED; PG8_LDA(At, 0, 0); PG8_STAGE(PG8_SA(1, 1), a1 + hstepA, voffA);
            PG8_WAIT_L(8); PG8_BAR; PG8_WAIT_L(0); PG8_MMA(0, 0, At, B0); PG8_BAR; PG8_SCHED;
            PG8_LDB(B1, 0, 1); PG8_STAGE(PG8_SB(0, 0), b2, voffB);
            PG8_BAR; PG8_WAIT_L(0); PG8_MMA(0, 1, At, B1); PG8_BAR;
            PG8_LDA(At, 0, 1); PG8_STAGE(PG8_SA(0, 0), a2, voffA);
            PG8_BAR; PG8_WAIT_L(0); PG8_MMA(1, 0, At, B0); PG8_BAR; PG8_SCHED;
            PG8_STAGE(PG8_SB(0, 1), b2 + hstepB, voffB);
            PG8_WAIT_V(6); PG8_BAR; PG8_MMA(1, 1, At, B1); PG8_BAR;
            PG8_LDB(B0, 1, 0); PG8_SCHED; PG8_LDA(At, 1, 0); PG8_STAGE(PG8_SA(0, 1), a2 + hstepA, voffA);
            PG8_WAIT_L(8); PG8_BAR; PG8_WAIT_L(0); PG8_MMA(0, 0, At, B0); PG8_BAR; PG8_SCHED;
            PG8_LDB(B1, 1, 1); PG8_STAGE(PG8_SB(1, 0), b3, voffB);
            PG8_BAR; PG8_WAIT_L(0); PG8_MMA(0, 1, At, B1); PG8_BAR;
            PG8_LDA(At, 1, 1); PG8_STAGE(PG8_SA(1, 0), a3, voffA);
            PG8_BAR; PG8_WAIT_L(0); PG8_MMA(1, 0, At, B0); PG8_BAR; PG8_SCHED;
            PG8_STAGE(PG8_SB(1, 1), b3 + hstepB, voffB);
            PG8_WAIT_V(6); PG8_BAR; PG8_MMA(1, 1, At, B1); PG8_BAR;
            }
        }
        if constexpr (ALIGN_EPI) { if (wr == 0) PG8_BAR; }
        { const int l2_ = lane_id(); E(acc, cur, wr, wc, l2_ & 15, l2_ >> 4); } S.done(cur);
        if (!has_next) break;
#pragma unroll
        for (int a = 0; a < 2; ++a)
#pragma unroll
            for (int b = 0; b < 2; ++b)
#pragma unroll
                for (int m = 0; m < 4; ++m)
#pragma unroll
                    for (int n = 0; n < 2; ++n) acc[a][b][m][n] = (f32x4){0.f, 0.f, 0.f, 0.f};
        cur = nxt; cA = nA; cB = nB; ++ui;
        if constexpr (ALIGN_EPI) { if (wr == 1) PG8_BAR; }
    }
    PG8_WAIT_V(0);
    if constexpr (!ALIGN_EPI) { if (wr == 0) PG8_BAR; }
    PG8_BAR;
#undef PG8_SA
#undef PG8_SB
#undef PG8_STAGE
#undef PG8_LDA
#undef PG8_LDB
#undef PG8_MMA
#undef PG8_ACOL
}
#define EPI_BAR() do { asm volatile("s_waitcnt lgkmcnt(0)" ::: "memory"); __builtin_amdgcn_s_barrier(); asm volatile("" ::: "memory"); } while (0)

#define EPI_FENCE() asm volatile("" ::: "memory")
__device__ __forceinline__ void rope_rows(f32x4 (&a)[2][2][4][2], int bj, const float* cs, int row0, int fq) {
#pragma unroll
    for (int ai = 0; ai < 2; ++ai)
#pragma unroll
        for (int m = 0; m < 4; ++m) { const float* cr = cs + (size_t)(row0 + ai * HALF + m * 16) * 32 + 8 * (fq & 1);
            const f32x4 c0 = *(const f32x4*)(cr), c1 = *(const f32x4*)(cr + 4), s0 = *(const f32x4*)(cr + 16), s1 = *(const f32x4*)(cr + 20);
            f32x4 v0 = a[ai][bj][m][0], v1 = a[ai][bj][m][1], p0, p1;
#pragma unroll
            for (int j = 0; j < 4; ++j) { p0[j] = __shfl_xor(v0[j], 32); p1[j] = __shfl_xor(v1[j], 32); }
            a[ai][bj][m][0] = (fq < 2) ? (v0 * c0 - p0 * s0) : (v0 * c0 + p0 * s0);
            a[ai][bj][m][1] = (fq < 2) ? (v1 * c1 - p1 * s1) : (v1 * c1 + p1 * s1);
            EPI_FENCE(); }
}
__device__ __forceinline__ void store_rows_bf16(const f32x4 (&acc)[2][2][4][2], bf16_t* base, int ld, int row0, int col0) {
#pragma unroll
    for (int ai = 0; ai < 2; ++ai)
#pragma unroll
        for (int m = 0; m < 4; ++m) { bf16_t* rowp = base + (size_t)(row0 + ai * HALF + m * 16) * ld + col0;
#pragma unroll
            for (int bj = 0; bj < 2; ++bj) { const f32x4 v0 = acc[ai][bj][m][0], v1 = acc[ai][bj][m][1];
                u32x4 w; w.x = cvt_pk_bf16(v0[0], v0[1]); w.y = cvt_pk_bf16(v0[2], v0[3]); w.z = cvt_pk_bf16(v1[0], v1[1]); w.w = cvt_pk_bf16(v1[2], v1[3]);
                *(u32x4*)(rowp + bj * HALF) = w; } }
}
struct EpiInProj {
    static constexpr bool PERM = true;
    bf16_t* proj; const float* ssq; float* dtb; const float* cs; const float* dt_bias; PG8_LAS float* xch; PG8_LAS float* rsl; int pm_cached;
    __device__ __forceinline__ void operator()(f32x4 (&acc)[2][2][4][2], const Unit& u, int wr, int wc, int fr, int fq) const {
        const int row0 = u.pm * BM + wr * 64 + fr;
        if (u.pm == pm_cached) {
#pragma unroll
            for (int ai = 0; ai < 2; ++ai)
#pragma unroll
                for (int m = 0; m < 4; ++m) { const float rs = rsl[ai * HALF + wr * 64 + m * 16 + fr];
#pragma unroll
                    for (int bj = 0; bj < 2; ++bj)
#pragma unroll
                        for (int n = 0; n < 2; ++n) acc[ai][bj][m][n] = acc[ai][bj][m][n] * rs; }
        } else {
#pragma unroll
            for (int ai = 0; ai < 2; ++ai)
#pragma unroll
                for (int m = 0; m < 4; ++m) { const int r = row0 + ai * HALF + m * 16;
                    const float s = (ssq[r] + ssq[T + r]) + (ssq[2 * T + r] + ssq[3 * T + r]); const float rs = 1.0f / sqrtf(s * (1.0f / DM) + NORM_EPS);
#pragma unroll
                    for (int bj = 0; bj < 2; ++bj)
#pragma unroll
                        for (int n = 0; n < 2; ++n) acc[ai][bj][m][n] = acc[ai][bj][m][n] * rs;
                    EPI_FENCE(); }
        }
        if (u.pn >= 11) {
            const bool t11 = (u.pn == 11);
#pragma unroll
            for (int ai = 0; ai < 2; ++ai)
#pragma unroll
                for (int m = 0; m < 4; ++m) { float s = 0.f;
#pragma unroll
                    for (int n = 0; n < 2; ++n) { const f32x4 x = acc[ai][0][m][n]; s += (x[0] * x[0] + x[1] * x[1]) + (x[2] * x[2] + x[3] * x[3]); }
                    if (t11) {
#pragma unroll
                        for (int n = 0; n < 2; ++n) { const f32x4 x = acc[ai][1][m][n]; s += (x[0] * x[0] + x[1] * x[1]) + (x[2] * x[2] + x[3] * x[3]); } }
                    s += __shfl_xor(s, 16); s += __shfl_xor(s, 32);
                    if (fq == 0) xch[(ai * HALF + wr * 64 + m * 16 + fr) * 4 + wc] = s; }
            EPI_BAR();
#pragma unroll
            for (int ai = 0; ai < 2; ++ai)
#pragma unroll
                for (int m = 0; m < 4; ++m) { const f32x4 p = *(const PG8_LAS f32x4*)(xch + (ai * HALF + wr * 64 + m * 16 + fr) * 4);
                    const float tot = (p[0] + p[1]) + (p[2] + p[3]); const float rn = 1.0f / sqrtf(tot * (t11 ? (1.0f / 256.f) : (1.0f / 128.f)) + NORM_EPS);
#pragma unroll
                    for (int n = 0; n < 2; ++n) { acc[ai][0][m][n] = acc[ai][0][m][n] * rn; if (t11) acc[ai][1][m][n] = acc[ai][1][m][n] * rn; } }
            EPI_BAR();
            if (!t11) {
                if (wc == 0) rope_rows(acc, 1, cs, row0, fq);
                else if (wc == 1 && fq == 0) {
#pragma unroll
                    for (int ai = 0; ai < 2; ++ai)
#pragma unroll
                        for (int m = 0; m < 4; ++m) { const int r = row0 + ai * HALF + m * 16; const f32x4 a0 = acc[ai][1][m][0], a1 = acc[ai][1][m][1];
                            *(f32x4*)(dtb + (size_t)r * 8) = a0; *(f32x4*)(dtb + (size_t)r * 8 + 4) = a1; }
                }
            }
        }
        store_rows_bf16(acc, proj, NP, row0, u.pn * BM + wc * 32 + 8 * fq);
    }
};
struct EpiQKV {
    static constexpr bool PERM = true;
    bf16_t* qkv; const float* cs;
    __device__ __forceinline__ void operator()(f32x4 (&acc)[2][2][4][2], const Unit& u, int wr, int wc, int fr, int fq) const {
        const int row0 = u.pm * BM + wr * 64 + fr;
#pragma unroll
        for (int bj = 0; bj < 2; ++bj) { const int cb = u.pn * BM + bj * HALF + wc * 32;
            if (cb >= QC_QR && cb < QC_QR + 192) rope_rows(acc, bj, cs, row0, fq); }
        store_rows_bf16(acc, qkv, NQKV, row0, u.pn * BM + wc * 32 + 8 * fq);
    }
};
struct EpiOut {
    static constexpr bool PERM = false;
    const float* base; float* xo; bf16_t* xb; float* ssq; PG8_LAS float* xch;
    __device__ __forceinline__ void operator()(f32x4 (&acc)[2][2][4][2], const Unit& u, int wr, int wc, int fr, int fq) const {
        const int row0 = u.pm * BM + wr * 64 + fr, col0 = u.pn * BM + wc * 32 + 4 * fq;
#pragma unroll
        for (int ai = 0; ai < 2; ++ai)
#pragma unroll
            for (int m = 0; m < 4; ++m) { const size_t off = (size_t)(row0 + ai * HALF + m * 16) * DM + col0; float s = 0.f;
#pragma unroll
                for (int bj = 0; bj < 2; ++bj)
#pragma unroll
                    for (int n = 0; n < 2; ++n) { const f32x4 v = *(const f32x4*)(base + off + bj * HALF + n * 16) + acc[ai][bj][m][n];
                        *(f32x4*)(xo + off + bj * HALF + n * 16) = v; s += (v[0] * v[0] + v[1] * v[1]) + (v[2] * v[2] + v[3] * v[3]);
                        if (xb) { u32x2 w; w.x = cvt_pk_bf16(v[0], v[1]); w.y = cvt_pk_bf16(v[2], v[3]); *(u32x2*)(xb + off + bj * HALF + n * 16) = w; } }
                s += __shfl_xor(s, 16); s += __shfl_xor(s, 32);
                if (fq == 0) xch[(ai * HALF + wr * 64 + m * 16 + fr) * 4 + wc] = s; }
        EPI_BAR();
        const int tid_ = (wr * 4 + wc) * 64 + fq * 16 + fr;
        if (tid_ < 256) { const f32x4 p = *(const PG8_LAS f32x4*)(xch + tid_ * 4); ssq[(size_t)u.pn * T + u.pm * BM + tid_] = (p[0] + p[1]) + (p[2] + p[3]); }
        EPI_BAR();
    }
};
}

__device__ __forceinline__ void p1_inproj(Frame& F, const Args& a, int l) {
    FRAME_IDS;
    pg8::Gemm g{(const bf16*)(F.dout + DO_XB), (const bf16*)(F.ws + WS_WIN) + (size_t)l * NP * DM, DM, DM, DM, 0, 0, 0};
    pg8::StaticOrder S; S.init(T, NP, F.G, F.bid);
    LAS float* rsl = (LAS float*)(F.lds + XCH_OFF + 4096); const float* ssq = (const float*)(F.ws + WS_SSQ);
    pg8::Unit u0; int pm0 = -1;
    if (S.next(0, u0)) { pm0 = u0.pm;
        if (tid < 256) { const int r = pm0 * 256 + tid; const float s = (ssq[r] + ssq[T + r]) + (ssq[2 * T + r] + ssq[3 * T + r]); rsl[tid] = 1.0f / sqrtf(s * (1.0f / DM) + NORM_EPS); } }
    __syncthreads();
    pg8::EpiInProj E{(bf16*)(F.ws + WS_PROJ), ssq, (float*)(F.ws + WS_DT), (const float*)(F.ws + WS_CS), a.ssd_dt_bias + l * 6, (LAS float*)(F.lds + XCH_OFF), rsl, pm0};
    pg8::gemm_phase<pg8::EpiInProj, pg8::StaticOrder, true, true>(F.lds, g, S, E, F.wave, lane_id());
}
__device__ __forceinline__ void p2_qkv(Frame& F, int l) {
    pg8::Gemm g{(const bf16*)(F.ws + WS_PROJ), (const bf16*)(F.ws + WS_WQKV) + (size_t)l * NQKV * 256, NP, 256, 256, PC_QA, PC_KV, 3};
    pg8::StaticOrder S; S.init(T, NQKV, F.G, F.bid);
    pg8::EpiQKV E{(bf16*)(F.dout + DO_QKV), (const float*)(F.ws + WS_CS)};
    pg8::gemm_phase<pg8::EpiQKV, pg8::StaticOrder, true, true>(F.lds, g, S, E, F.wave, lane_id());
}
__device__ __forceinline__ void p4_outproj(Frame& F, const Args& a, int l) {
    pg8::Gemm g{(const bf16*)(F.ws + WS_Y), (const bf16*)(F.ws + WS_WOUT) + (size_t)l * DM * DM, DM, DM, DM, 0, 0, 0};
    pg8::StaticOrder S; S.init(T, DM, F.G, F.bid);
    pg8::EpiOut E{l == 0 ? a.x : (const float*)(F.ws + WS_XRES), l == 0 ? (float*)(F.ws + WS_XRES) : a.out, l == 0 ? (bf16*)(F.dout + DO_XB) : (bf16*)nullptr, (float*)(F.ws + WS_SSQ), (LAS float*)(F.lds + XCH_OFF)};
    pg8::gemm_phase<pg8::EpiOut, pg8::StaticOrder, true, true>(F.lds, g, S, E, F.wave, lane_id());
}

__device__ __forceinline__ void p2_conva(Frame& F, const Args& a, int l) {
    FRAME_IDS;
    const bf16* proj = (const bf16*)(F.ws + WS_PROJ); bf16* y = (bf16*)(F.ws + WS_Y); const float* cw = a.conv_a_w + (size_t)l * 3 * 256;
    const size_t total = (size_t)T * 256;
    for (size_t e = (size_t)F.bid * NTHR + tid; e < total; e += (size_t)F.G * NTHR) {
        const int r = (int)(e >> 8), c = (int)(e & 255), s = r % SEQ;
        float conv = 0.f;
#pragma unroll
        for (int k = 0; k < 3; ++k) { const int ds = s - 2 + k; if (ds >= 0) { const bf16* pr = proj + (size_t)(r - 2 + k) * NP; conv += cw[k * 256 + c] * (bf2f(pr[PC_AC + c]) * bf2f(pr[PC_AH + c])); } }
        const bf16* pr = proj + (size_t)r * NP;
        y[(size_t)r * DM + YC_A + c] = (bf16)f2bf(bf2f(pr[PC_AB + c]) * conv * silu_f(bf2f(pr[PC_AZ + c])));
    }
}
__device__ __forceinline__ void p3_attn_naive(Frame& F) {
    FRAME_IDS;
    const bf16* qkv = (const bf16*)(F.dout + DO_QKV); const bf16* proj = (const bf16*)(F.ws + WS_PROJ); bf16* y = (bf16*)(F.ws + WS_Y);
    const int total = BATCH * NHEAD * SEQ;
    for (int e = F.bid * NTHR + tid; e < total; e += F.G * NTHR) {
        const int q = e % SEQ, h = (e / SEQ) % NHEAD, b = e / (SEQ * NHEAD); const size_t r = (size_t)b * SEQ + q;
        unsigned qp[48]; float o[64];
#pragma unroll
        for (int d = 0; d < 32; ++d) qp[d] = *(const GAS unsigned*)(qkv + r * NQKV + QC_QN + h * 64 + 2 * d);
#pragma unroll
        for (int d = 0; d < 16; ++d) qp[32 + d] = *(const GAS unsigned*)(qkv + r * NQKV + QC_QR + h * 32 + 2 * d);
#pragma unroll
        for (int d = 0; d < 64; ++d) o[d] = 0.f;
        float m = -INFINITY, lsum = 0.f;
        for (int j = 0; j <= q; ++j) {
            const size_t rj = (size_t)b * SEQ + j; const bf16* kn = qkv + rj * NQKV + QC_KN + h * 64; const bf16* kr = proj + rj * NP + PC_KR; const bf16* vv = qkv + rj * NQKV + QC_V + h * 64;
            float s = 0.f;
#pragma unroll
            for (int d = 0; d < 32; ++d) { const unsigned w = *(const GAS unsigned*)(kn + 2 * d); s += bflo(qp[d]) * bflo(w) + bfhi(qp[d]) * bfhi(w); }
#pragma unroll
            for (int d = 0; d < 16; ++d) { const unsigned w = *(const GAS unsigned*)(kr + 2 * d); s += bflo(qp[32 + d]) * bflo(w) + bfhi(qp[32 + d]) * bfhi(w); }
            const float mn = fmaxf(m, s), f = exp2f(m - mn), p = exp2f(s - mn);
            lsum = lsum * f + p; m = mn;
#pragma unroll
            for (int d = 0; d < 64; d += 2) { const unsigned w = *(const GAS unsigned*)(vv + d); o[d] = o[d] * f + p * bflo(w); o[d + 1] = o[d + 1] * f + p * bfhi(w); }
        }
        const float inv = 1.f / lsum; const bf16* cz = proj + r * NP + PC_CZ + h * 64;
#pragma unroll
        for (int d = 0; d < 64; ++d) y[r * DM + YC_C + h * 64 + d] = (bf16)f2bf(o[d] * inv * silu_f(bf2f(cz[d])));
    }
}
__device__ __forceinline__ void p3_ssd_naive(Frame& F, const Args& a, int l) {
    FRAME_IDS;
    const bf16* proj = (const bf16*)(F.ws + WS_PROJ); const float* dtb = (const float*)(F.ws + WS_DT); float* ys = (float*)(F.ws + WS_ST);
    const float* cw = a.ssd_conv_w + (size_t)l * 4 * 896; const float* cb = a.ssd_conv_b + (size_t)l * 896;
    LAS float* bc = (LAS float*)F.lds;
    for (int u = F.bid; u < BATCH * SSD_G; u += F.G) {
        const int b = u / SSD_G, g = u % SSD_G;
        const int hh = tid / 64, p = tid % 64, h = g * 3 + hh;
        float st[128];
#pragma unroll
        for (int n = 0; n < 128; ++n) st[n] = 0.f;
        const float A = tid < 192 ? -__expf(a.ssd_a_log[l * 6 + h]) : 0.f, Dk = tid < 192 ? a.ssd_d[l * 6 + h] : 0.f, dtbias = tid < 192 ? a.ssd_dt_bias[l * 6 + h] : 0.f;
        const int xc = hh * 64 + p + g * 192;
        for (int s = 0; s < SEQ; ++s) {
            const size_t r = (size_t)b * SEQ + s;
            if (tid < 256) {
                const int ch = tid < 128 ? 384 + g * 128 + tid : 640 + g * 128 + (tid - 128);
                const int pc = tid < 128 ? PC_SB + g * 128 + tid : PC_SC + g * 128 + (tid - 128);
                float v = cb[ch];
#pragma unroll
                for (int k = 0; k < 4; ++k) { const int ds = s - 3 + k; if (ds >= 0) v += cw[k * 896 + ch] * bf2f(proj[(r - 3 + k) * NP + pc]); }
                bc[tid] = silu_f(v);
            }
            __syncthreads();
            if (tid < 192) {
                float xv = cb[xc];
#pragma unroll
                for (int k = 0; k < 4; ++k) { const int ds = s - 3 + k; if (ds >= 0) xv += cw[k * 896 + xc] * bf2f(proj[(r - 3 + k) * NP + PC_SX + xc]); }
                xv = silu_f(xv);
                const float dt = softplus_f(dtb[r * 8 + h] + dtbias), dec = __expf(dt * A), xd = xv * dt;
                float yv = 0.f;
#pragma unroll
                for (int n = 0; n < 128; ++n) { st[n] = st[n] * dec + xd * bc[n]; yv += st[n] * bc[128 + n]; }
                ys[r * 384 + xc] = yv + xv * Dk;
            }
            __syncthreads();
        }
    }
}
__device__ __forceinline__ void p3b_ssd_gate_naive(Frame& F, const Args& a, int l) {
    FRAME_IDS;
    const bf16* proj = (const bf16*)(F.ws + WS_PROJ); const float* ys = (const float*)(F.ws + WS_ST); bf16* y = (bf16*)(F.ws + WS_Y);
    const float* ng = a.ssd_norm_g + (size_t)l * 384;
    const int gw = F.bid * NWAVES + F.wave, NGW = F.G * NWAVES;
    for (int e = gw; e < T * 2; e += NGW) {
        const int r = e >> 1, g = e & 1; float v[3]; float s = 0.f;
#pragma unroll
        for (int j = 0; j < 3; ++j) { const int c = g * 192 + lane + 64 * j; v[j] = ys[(size_t)r * 384 + c] * silu_f(bf2f(proj[(size_t)r * NP + PC_SZ + c])); s += v[j] * v[j]; }
        s = wave_sum(s); const float rn = 1.0f / sqrtf(s * (1.0f / 192.f) + SSD_NORM_EPS);
#pragma unroll
        for (int j = 0; j < 3; ++j) { const int c = g * 192 + lane + 64 * j; y[(size_t)r * DM + YC_B + c] = (bf16)f2bf(v[j] * rn * ng[c]); }
    }
}
__device__ __forceinline__ void p5_final(Frame& F, const Args& a) {
    FRAME_IDS;
    const float* ssq = (const float*)(F.ws + WS_SSQ);
    const int gw = F.bid * NWAVES + F.wave, NGW = F.G * NWAVES;
    for (int m = gw; m < T; m += NGW) {
        GAS f32x4* xr = (GAS f32x4*)(a.out + (size_t)m * DM) + lane; const GAS f32x4* gr = (const GAS f32x4*)a.final_norm_g + lane;
        const float s = (ssq[m] + ssq[T + m]) + (ssq[2 * T + m] + ssq[3 * T + m]); const float rs = 1.0f / sqrtf(s * (1.0f / DM) + NORM_EPS);
#pragma unroll
        for (int j = 0; j < 4; ++j) { const f32x4 v = xr[64 * j], g = gr[64 * j]; xr[64 * j] = v * rs * g; }
    }
}

constexpr int PH_PER_LAYER = 5, N_PHASES = 1 + DEPTH * PH_PER_LAYER + 1;
__global__ void __launch_bounds__(NTHR, 2) fwd_kernel(Args args) {
    extern __shared__ __attribute__((aligned(16))) unsigned char lds[];
    Frame F;
    F.lds = (LAS unsigned char*)lds; F.wave = __builtin_amdgcn_readfirstlane((int)threadIdx.x >> 6);
    F.G = gridDim.x; F.bid = blockIdx.x; F.ws = args.ws; F.dout = (unsigned char*)args.out;
    volatile LAS unsigned* MISC = (volatile LAS unsigned*)(F.lds + MISC_OFF);
    if (threadIdx.x < 32) MISC[threadIdx.x] = 0u;
    __syncthreads();
    gu32* ctl = (gu32*)(F.ws + WS_CTL);
    XcdBarrier bar; bar.bar = (unsigned*)(ctl + CW_BAR); bar.x = 0; bar.st = nullptr;
    const bool multi = (args.ph_hi - args.ph_lo) > 1;
    if (multi) bar = xcd_barrier_post((unsigned*)(ctl + CW_BAR), MISC + 8, threadIdx.x == 0);
    const int lo = args.ph_lo, hi = args.ph_hi;
#define IN(k) (lo <= (k) && (k) < hi)
#define SEAM(k) do { if (IN(k) && IN((k) + 1)) xcd_barrier(bar, F.wave == 0 && lane_id() == 0); } while (0)
    if (IN(0)) { p0_prologue(F, args); } SEAM(0);
#define LAYER(l) do { constexpr int pb = 1 + (l) * PH_PER_LAYER; \
        if (IN(pb + 0)) { p1_inproj(F, args, l); } SEAM(pb + 0); \
        if (IN(pb + 1)) { p2_qkv(F, l); p2_conva(F, args, l); } SEAM(pb + 1); \
        if (IN(pb + 2)) { p3_attn_naive(F); p3_ssd_naive(F, args, l); } SEAM(pb + 2); \
        if (IN(pb + 3)) { p3b_ssd_gate_naive(F, args, l); } SEAM(pb + 3); \
        if (IN(pb + 4)) { p4_outproj(F, args, l); } SEAM(pb + 4); } while (0)
    LAYER(0);
    LAYER(1);
    static_assert(DEPTH == 2, "two layers written out");
#undef LAYER
    if (IN(N_PHASES - 1)) p5_final(F, args);
#undef IN
#undef SEAM
}

extern "C" void kernel_launch(void* const* d_in, const int* in_sizes, int n_in, void* d_out, int out_size, void* d_ws, size_t ws_size, hipStream_t stream) {
    static int grid = 0;
    if (grid == 0) {
        if (n_in != 17 || in_sizes[0] != T * DM || out_size != T * DM || ws_size < WS_END) { fprintf(stderr, "kernel_launch: unexpected shapes (n_in %d, in0 %d, out %d, ws %zu)\n", n_in, n_in > 0 ? in_sizes[0] : -1, out_size, ws_size); grid = -1; return; }
        int dev = 0, cus = 0;
        if (hipGetDevice(&dev) != hipSuccess || hipDeviceGetAttribute(&cus, hipDeviceAttributeMultiprocessorCount, dev) != hipSuccess) { grid = -1; return; }
        if (hipFuncSetAttribute((const void*)fwd_kernel, hipFuncAttributeMaxDynamicSharedMemorySize, LDS_BYTES) != hipSuccess) { fprintf(stderr, "kernel_launch: hipFuncSetAttribute failed\n"); grid = -1; return; }
        int per_cu = 0;
        if (hipOccupancyMaxActiveBlocksPerMultiprocessor(&per_cu, (const void*)fwd_kernel, NTHR, LDS_BYTES) != hipSuccess || per_cu < 1) fprintf(stderr, "kernel_launch: occupancy query reports %d\n", per_cu);
        (void)hipGetLastError();
        grid = cus;
    }
    if (grid < 0) return;
    (void)hipMemsetAsync((char*)d_ws + WS_CTL, 0, CTL_ZERO_BYTES, stream);
    Args a{};
    a.x = (const float*)d_in[0]; a.pos = (const int*)d_in[1]; a.norm_g = (const float*)d_in[2]; a.w_in = (const float*)d_in[3]; a.conv_a_w = (const float*)d_in[4];
    a.ssd_conv_w = (const float*)d_in[5]; a.ssd_conv_b = (const float*)d_in[6]; a.ssd_dt_bias = (const float*)d_in[7]; a.ssd_a_log = (const float*)d_in[8]; a.ssd_d = (const float*)d_in[9];
    a.ssd_norm_g = (const float*)d_in[10]; a.mla_q_norm_g = (const float*)d_in[11]; a.w_qb = (const float*)d_in[12]; a.mla_kv_norm_g = (const float*)d_in[13]; a.w_kvb = (const float*)d_in[14];
    a.w_out = (const float*)d_in[15]; a.final_norm_g = (const float*)d_in[16];
    a.out = (float*)d_out; a.ws = (unsigned char*)d_ws;
#if MK_N_LAUNCHES == 1
    a.ph_lo = 0; a.ph_hi = N_PHASES;
    hipLaunchKernelGGL(fwd_kernel, dim3(grid), dim3(NTHR), LDS_BYTES, stream, a);
#else
    for (int ph = 0; ph < N_PHASES; ++ph) { a.ph_lo = ph; a.ph_hi = ph + 1; hipLaunchKernelGGL(fwd_kernel, dim3(grid), dim3(NTHR), LDS_BYTES, stream, a); }
#endif
}
```

```cpp
#include <hip/hip_runtime.h>
#include <cstdio>
#include <cstdint>

#ifndef MK_N_LAUNCHES
#define MK_N_LAUNCHES 1
#endif

constexpr int BATCH = 8, SEQ = 2048, DM = 1024, DEPTH = 2, T = BATCH * SEQ;
constexpr int IN_COLS = 3110;
constexpr int NP = 3328;
constexpr int PC_AH = 0, PC_AB = 256, PC_AC = 512, PC_AZ = 768, PC_SZ = 1024, PC_SX = 1408, PC_SB = 1792, PC_SC = 2048,
              PC_CZ = 2304, PC_QA = 2816, PC_KV = 3072, PC_KR = 3200, PC_DT = 3232;
constexpr int NQKV = 1536;
constexpr int QC_QN = 0, QC_QR = 384, QC_KN = 768, QC_V = 1152;
constexpr int YC_A = 0, YC_B = 256, YC_C = 640;
constexpr int NHEAD = 6, SSD_H = 6, SSD_P = 64, SSD_N = 128, SSD_G = 2, CHUNK = 128, NCHUNK = SEQ / CHUNK;
constexpr float NORM_EPS = 1e-6f, SSD_NORM_EPS = 1e-5f;
constexpr float ATT_C2 = 0.10206207261596577f * 1.4426950408889634f;

constexpr size_t MiB = 1u << 20;
constexpr size_t WS_CTL = 0, CTL_ZERO_BYTES = 64 * 1024;
constexpr size_t WS_WIN = 1 * MiB;
constexpr size_t WS_WQKV = WS_WIN + (size_t)DEPTH * NP * DM * 2;
constexpr size_t WS_WOUT = WS_WQKV + (size_t)DEPTH * NQKV * 256 * 2;
constexpr size_t WS_CS = WS_WOUT + (size_t)DEPTH * DM * DM * 2;
constexpr size_t WS_DT = WS_CS + (size_t)T * 32 * 4;
constexpr size_t WS_SSQ = WS_DT + (size_t)T * 8 * 4;
constexpr size_t WS_CDEC = WS_SSQ + (size_t)4 * T * 4;
constexpr size_t WS_XRES = 24 * MiB;
constexpr size_t WS_PROJ = WS_XRES + (size_t)T * DM * 4;
constexpr size_t WS_Y = WS_PROJ + (size_t)T * NP * 2;
constexpr size_t WS_ST = WS_Y + (size_t)T * DM * 2;
constexpr size_t WS_END = WS_ST + (size_t)T * 384 * 4;
static_assert(WS_CDEC + (size_t)BATCH * NCHUNK * 8 * 4 <= WS_XRES, "ws map (small)");
static_assert(WS_END <= 256 * MiB, "ws map");
constexpr size_t DO_QKV = 0;
constexpr size_t DO_XB = 0;
constexpr size_t DO_TMP = 32 * MiB;

constexpr int CW_TMO = 0, CW_BAR = 1024, CW_Q = 8192;

constexpr int RING_BYTES = 131072, XCH_OFF = RING_BYTES, XCH_BYTES = 8192, MISC_OFF = XCH_OFF + XCH_BYTES, LDS_BYTES = 147456;
constexpr int NWAVES = 8, NTHR = NWAVES * 64;

#define GAS __attribute__((address_space(1)))
#define LAS __attribute__((address_space(3)))
typedef unsigned short bf16;
typedef unsigned v4u __attribute__((ext_vector_type(4)));
typedef unsigned v2u __attribute__((ext_vector_type(2)));
typedef float f32x4 __attribute__((ext_vector_type(4)));
typedef short bf16x8 __attribute__((ext_vector_type(8)));
typedef GAS unsigned gu32;
#define RLX_AGENT __ATOMIC_RELAXED, __HIP_MEMORY_SCOPE_AGENT
#define LDS_WAIT() asm volatile("s_waitcnt lgkmcnt(0)" ::: "memory")
#define VM_WAIT() asm volatile("s_waitcnt vmcnt(0)" ::: "memory")

__device__ __forceinline__ unsigned f2bf(float f) { unsigned u = __builtin_bit_cast(unsigned, f); return (u + 0x7fffu + ((u >> 16) & 1u)) >> 16; }
__device__ __forceinline__ unsigned pk2(float lo, float hi) { return f2bf(lo) | (f2bf(hi) << 16); }
__device__ __forceinline__ float bf2f(unsigned short b) { return __builtin_bit_cast(float, (unsigned)b << 16); }
__device__ __forceinline__ float bflo(unsigned w) { return __builtin_bit_cast(float, w << 16); }
__device__ __forceinline__ float bfhi(unsigned w) { return __builtin_bit_cast(float, w & 0xffff0000u); }
__device__ __forceinline__ float silu_f(float x) { return x / (1.f + __expf(-x)); }
__device__ __forceinline__ float softplus_f(float x) { return fmaxf(x, 0.f) + log1pf(__expf(-fabsf(x))); }

#define XB_TMO      128
#define XB_XCNT(j)  (256  + 64 * (j))
#define XB_XSUB(j)  (1280 + 64 * (j))
#define XB_XGEN(j)  (2304 + 64 * (j))
#define XB_TOP      3328
#define XB_TOPGEN   3392
#define XCD_BAR_WORDS 3456
#define XB_SPIN_CAP (1u << 22)
__device__ __forceinline__ unsigned xb_ld(unsigned* p)              { return __hip_atomic_load(p, __ATOMIC_RELAXED, __HIP_MEMORY_SCOPE_AGENT); }
__device__ __forceinline__ unsigned xb_add(unsigned* p, unsigned v) { return __hip_atomic_fetch_add(p, v, __ATOMIC_RELAXED, __HIP_MEMORY_SCOPE_AGENT); }
__device__ __forceinline__ unsigned xb_xcc_id() { return (unsigned)__builtin_amdgcn_s_getreg((3 << 11) | 20) & 0xFu; }
#define XB_SPIN(cond, bar) do { unsigned _sp = 0; while (cond) { __builtin_amdgcn_s_sleep(1); \
    if ((++_sp & 255u) == 0u) { if (xb_ld(&(bar)[XB_TMO])) break; if (_sp > XB_SPIN_CAP) { atomicAdd(&(bar)[XB_TMO], 1u); break; } } } } while (0)
struct XcdBarrier { unsigned* bar; unsigned x; volatile LAS unsigned* st; };
__device__ __forceinline__ XcdBarrier xcd_barrier_post(unsigned* bar, volatile LAS unsigned* st, bool leader) {
    XcdBarrier b; b.bar = bar; b.x = xb_xcc_id(); b.st = st;
    if (leader) (void)xb_add(&bar[XB_XCNT(b.x)], 1u);
    return b;
}
__device__ __forceinline__ void xcd_barrier_complete(unsigned* bar, unsigned x, unsigned& nloc, unsigned& nx) {
    const unsigned G = gridDim.x * gridDim.y * gridDim.z;
    unsigned sum, cnt, mine, sp = 0u;
    for (;;) {
        sum = 0u; cnt = 0u; mine = 0u;
#pragma unroll
        for (unsigned j = 0; j < 16; ++j) { const unsigned c = xb_ld(&bar[XB_XCNT(j)]); sum += c; cnt += (c > 0u) ? 1u : 0u; mine = (j == x) ? c : mine; }
        if (sum == G) break;
        __builtin_amdgcn_s_sleep(1);
        if ((++sp & 255u) == 0u) { if (xb_ld(&bar[XB_TMO])) break; if (sp > XB_SPIN_CAP) { atomicAdd(&bar[XB_TMO], 1u); break; } }
    }
    nloc = mine > 0u ? mine : 1u; nx = cnt > 0u ? cnt : 1u;
}
__device__ __forceinline__ void xcd_barrier(const XcdBarrier& b, bool leader) {
    asm volatile("s_waitcnt vmcnt(0)" ::: "memory");
    __syncthreads();
    if (leader) {
        unsigned* bar = b.bar;
        __builtin_amdgcn_s_waitcnt(0);
        unsigned nloc = b.st[0], nx = b.st[1];
        if (nloc == 0u) { xcd_barrier_complete(bar, b.x, nloc, nx); b.st[0] = nloc; b.st[1] = nx; }
        const unsigned old = xb_add(&bar[XB_XSUB(b.x)], 1u);
        const unsigned gen = old / nloc;
        if (old + 1u == (gen + 1u) * nloc) {
            __builtin_amdgcn_fence(__ATOMIC_RELEASE, "agent");
            asm volatile("s_waitcnt vmcnt(0)" ::: "memory");
            const unsigned og = xb_add(&bar[XB_TOP], 1u);
            const unsigned tg = og / nx;
            if (og + 1u == (tg + 1u) * nx) xb_add(&bar[XB_TOPGEN], 1u);
            else XB_SPIN(xb_ld(&bar[XB_TOPGEN]) == tg, bar);
            __builtin_amdgcn_fence(__ATOMIC_ACQUIRE, "agent");
            xb_add(&bar[XB_XGEN(b.x)], 1u);
            asm volatile("s_waitcnt vmcnt(0)" ::: "memory");
        } else {
            XB_SPIN(xb_ld(&bar[XB_XGEN(b.x)]) == gen, bar);
            __builtin_amdgcn_fence(__ATOMIC_ACQUIRE, "agent");
            asm volatile("s_waitcnt vmcnt(0)" ::: "memory");
        }
    }
    __syncthreads();
}

struct Args {
    const float* x; const int* pos; const float* norm_g; const float* w_in; const float* conv_a_w; const float* ssd_conv_w; const float* ssd_conv_b;
    const float* ssd_dt_bias; const float* ssd_a_log; const float* ssd_d; const float* ssd_norm_g; const float* mla_q_norm_g; const float* w_qb;
    const float* mla_kv_norm_g; const float* w_kvb; const float* w_out; const float* final_norm_g;
    float* out; unsigned char* ws; int ph_lo, ph_hi;
};
typedef const __attribute__((address_space(4))) Args* KArgs;
struct Frame {
    LAS unsigned char* lds; int wave, G, bid;
    unsigned char* ws; unsigned char* dout;
};
__device__ __forceinline__ int lane_id() { int l; asm volatile("v_mbcnt_lo_u32_b32 %0, -1, 0\n\tv_mbcnt_hi_u32_b32 %0, -1, %0" : "=v"(l)); return l; }
#define FRAME_IDS const int lane = lane_id(), tid = F.wave * 64 + lane; (void)tid; (void)lane
__device__ __forceinline__ float wave_sum(float v) {
#pragma unroll
    for (int o = 1; o < 64; o <<= 1) v += __shfl_xor(v, o);
    return v;
}

__device__ __forceinline__ int win_src_col(int n) {
    if (n < 2304) return n;
    if (n < 2688) return 2726 + (n - 2304);
    if (n < 2816) return -1;
    if (n < 3072) return 2310 + (n - 2816);
    if (n < 3200) return 2566 + (n - 3072);
    if (n < 3232) return 2694 + (n - 3200);
    if (n < 3238) return 2304 + (n - 3232);
    return -1;
}
__device__ __forceinline__ int wqkv_src_col(int n, int& which) {
    if (n < 384) { which = 0; return (n >> 6) * 96 + (n & 63); }
    if (n < 576) { which = 0; const int r = n - 384; return (r >> 5) * 96 + 64 + (r & 31); }
    if (n < 768) { which = -1; return -1; }
    if (n < 1152) { which = 1; const int r = n - 768; return (r >> 6) * 128 + (r & 63); }
    which = 1; const int r = n - 1152; return (r >> 6) * 128 + 64 + (r & 63);
}

template <class SrcFn>
__device__ __forceinline__ void transpose_item(const SrcFn& src, int K, bf16* WT, LAS float* scr, int kb, int nb, int lane) {
    const int k0 = 64 * kb, n0 = 32 * nb;
#pragma unroll 8
    for (int i = 0; i < 32; ++i) { const int kk = 2 * i + (lane >> 5); scr[kk * 33 + (lane & 31)] = src(k0 + kk, n0 + (lane & 31)); }
    LDS_WAIT(); asm volatile("" ::: "memory");
    const int c = lane & 7;
#pragma unroll
    for (int j = 0; j < 4; ++j) { const int n = (lane >> 3) + 8 * j; const LAS float* s = scr + (8 * c) * 33 + n;
        v4u o; o.x = pk2(s[0 * 33], s[1 * 33]); o.y = pk2(s[2 * 33], s[3 * 33]); o.z = pk2(s[4 * 33], s[5 * 33]); o.w = pk2(s[6 * 33], s[7 * 33]);
        *(GAS v4u*)(WT + (size_t)(n0 + n) * K + k0 + 8 * c) = o; }
    LDS_WAIT(); asm volatile("" ::: "memory");
}
__device__ __forceinline__ void p0_prologue(Frame& F, KArgs a) {
    FRAME_IDS;
    LAS float* scr = (LAS float*)(F.lds + F.wave * 16384);
    const int gw = F.bid * NWAVES + F.wave, NGW = F.G * NWAVES;
    bf16* Win_t = (bf16*)(F.ws + WS_WIN); bf16* Wqkv_t = (bf16*)(F.ws + WS_WQKV); bf16* Wout_t = (bf16*)(F.ws + WS_WOUT);
    constexpr int I_IN = (DM / 64) * (NP / 32), I_QKV = (256 / 64) * (NQKV / 32), I_OUT = (DM / 64) * (DM / 32), I_L = I_IN + I_QKV + I_OUT;
    for (int it = gw; it < DEPTH * I_L; it += NGW) {
        const int l = it / I_L; int r = it % I_L;
        if (r < I_IN) {
            const float* W = a->w_in + (size_t)l * DM * IN_COLS; const float* g = a->norm_g + l * DM;
            auto src = [&](int k, int n) -> float { const int sc = win_src_col(n); return sc < 0 ? 0.f : W[(size_t)k * IN_COLS + sc] * g[k]; };
            transpose_item(src, DM, Win_t + (size_t)l * NP * DM, scr, r / (NP / 32), r % (NP / 32), lane); continue; }
        r -= I_IN;
        if (r < I_QKV) {
            const float* Wq = a->w_qb + (size_t)l * 256 * 576; const float* Wkv = a->w_kvb + (size_t)l * 128 * 768;
            const float* gq = a->mla_q_norm_g + l * 256; const float* gkv = a->mla_kv_norm_g + l * 128;
            auto src = [&](int k, int n) -> float { int which; const int sc = wqkv_src_col(n, which);
                if (which == 0) return Wq[(size_t)k * 576 + sc] * gq[k] * ATT_C2;
                if (which == 1) return k < 128 ? Wkv[(size_t)k * 768 + sc] * gkv[k] : 0.f;
                return 0.f; };
            transpose_item(src, 256, Wqkv_t + (size_t)l * NQKV * 256, scr, r / (NQKV / 32), r % (NQKV / 32), lane); continue; }
        r -= I_QKV;
        { const float* W = a->w_out + (size_t)l * DM * DM;
          auto src = [&](int k, int n) -> float { return W[(size_t)k * DM + n]; };
          transpose_item(src, DM, Wout_t + (size_t)l * DM * DM, scr, r / (DM / 32), r % (DM / 32), lane); }
    }
    bf16* xb = (bf16*)(F.dout + DO_XB); float* ssq = (float*)(F.ws + WS_SSQ);
    for (int m = gw; m < T; m += NGW) {
        const GAS f32x4* xr = (const GAS f32x4*)(a->x + (size_t)m * DM) + lane; GAS v2u* o8 = (GAS v2u*)(xb + (size_t)m * DM) + lane;
        float s = 0.f;
#pragma unroll
        for (int j = 0; j < 4; ++j) { const f32x4 v = xr[64 * j]; s += (v.x * v.x + v.y * v.y) + (v.z * v.z + v.w * v.w); v2u w; w.x = pk2(v.x, v.y); w.y = pk2(v.z, v.w); o8[64 * j] = w; }
        s = wave_sum(s);
        if (lane < 4) ssq[lane * T + m] = lane == 0 ? s : 0.f;
    }
    float* cs = (float*)(F.ws + WS_CS);
    for (int i = F.bid * NTHR + tid; i < T * 16; i += F.G * NTHR) {
        const int t = i >> 4, j = i & 15;
        const float inv = (float)pow(10000.0, -(double)(2 * j) / 32.0);
        const float ang = (float)a->pos[t] * inv;
        cs[(size_t)t * 32 + j] = cosf(ang); cs[(size_t)t * 32 + 16 + j] = sinf(ang);
    }
}


namespace pg8 {
#define PG8_LAS __attribute__((address_space(3)))
typedef unsigned short bf16_t;
typedef short bf16x8 __attribute__((ext_vector_type(8)));
typedef float f32x4 __attribute__((ext_vector_type(4)));
typedef unsigned u32x4 __attribute__((ext_vector_type(4)));
typedef unsigned u32x2 __attribute__((ext_vector_type(2)));
constexpr int BM = 256, BK = 64, HALF = 128, HTB = HALF * BK * 2, STAGE_BYTES = 8 * HTB, NXCD = 8, WGM = 8;
__host__ __device__ __forceinline__ int lds_byte(int r, int c) { const int st = (r >> 4) * 2 + (c >> 5), rr = r & 15, cc = c & 31, ob = rr * 64 + cc * 2; return st * 1024 + (ob ^ (((ob >> 9) & 1) << 5)); }
__host__ __device__ __forceinline__ void stage_rc(int b, int& R, int& C) { const int st = b / 1024, sb = b % 1024, swz = sb ^ (((sb >> 9) & 1) << 5); R = (st >> 1) * 16 + swz / 64; C = (st & 1) * 32 + (swz % 64) / 2; }
__host__ __device__ __forceinline__ int perm32(int rho) { const int n = rho >> 4, i = rho & 15; return 8 * (i >> 2) + 4 * n + (i & 3); }
struct Unit { int pm, pn; };
struct Gemm { const bf16_t* A; const bf16_t* Bt; int lda, ldb, K; int acol_lo, acol_hi, pn_split; };
struct StaticOrder {
    int nM, nN, nwg, G, c;
    __host__ __device__ void init(int M, int N, int G_, int c_) { nM = M / BM; nN = N / BM; nwg = nM * nN; G = G_; c = c_; }
    __host__ __device__ bool next(int i, Unit& u) const {
        const long L = (long)i * G + c; if (L >= nwg) return false;
        int wgid = (int)L; { const int q = nwg / NXCD, r = nwg % NXCD, xcd = wgid % NXCD, off = wgid / NXCD; wgid = (xcd < r ? xcd * (q + 1) : r * (q + 1) + (xcd - r) * q) + off; }
        const int nig = WGM * nN, gid = wgid / nig, fm = gid * WGM, gsz = (nM - fm) < WGM ? (nM - fm) : WGM;
        u.pm = fm + ((wgid % nig) % gsz); u.pn = (wgid % nig) / gsz; return true;
    }
    __device__ __forceinline__ void a_ready(const Unit&) const {}
    __device__ __forceinline__ void done(const Unit&) const {}
};
__device__ __forceinline__ unsigned cvt_pk_bf16(float lo, float hi) { unsigned r; asm volatile("v_cvt_pk_bf16_f32 %0, %1, %2" : "=v"(r) : "v"(lo), "v"(hi)); return r; }

template <class Epi, class Sched, bool ALIGN_EPI = false, bool SP2 = false>
__device__ __forceinline__ void gemm_phase(PG8_LAS unsigned char* lds, const Gemm g, const Sched& S, const Epi& E, int wid, int lane) {
    const int tid = wid * 64 + lane, wr = wid >> 2, wc = wid & 3, fr = lane & 15, fq = lane >> 4;
    const int K = g.K, nt = K / BK;
    unsigned voffA[2], voffB[2];
#pragma unroll
    for (int i = 0; i < 2; ++i) { int R, C; stage_rc(tid * 16 + i * 8192, R, C); const int Rb = Epi::PERM ? ((R & ~31) + perm32(R & 31)) : R;
        voffA[i] = (unsigned)(R * g.lda + C) * 2u; voffB[i] = (unsigned)(Rb * g.ldb + C) * 2u; }
    const size_t kstep = (size_t)(BK * 2);
    const size_t hstepA = (size_t)HALF * g.lda * 2, hstepB = (size_t)HALF * g.ldb * 2;
    const size_t tstepA = 2 * hstepA, tstepB = 2 * hstepB;
    const unsigned ldsw = (unsigned)wid * 1024u;
    const int aoff = lds_byte(wr * 64 + fr, fq * 8), boff = lds_byte(wc * 32 + fr, fq * 8);
#define PG8_SA(b, h) (((b) * 2 + (h)) * HTB)
#define PG8_SB(b, h) ((4 + (b) * 2 + (h)) * HTB)
#define PG8_STAGE(bufoff, gbase, voff) do { _Pragma("unroll") for (int _i = 0; _i < 2; ++_i) \
        __builtin_amdgcn_global_load_lds((const unsigned*)((const char*)(gbase) + (voff)[_i]), (PG8_LAS unsigned*)(lds + (bufoff) + ldsw + _i * 8192), 16, 0, 0); } while (0)
#define PG8_LDA(dst, b, h) do { _Pragma("unroll") for (int m = 0; m < 4; ++m) _Pragma("unroll") for (int k = 0; k < 2; ++k) dst[m][k] = *(const PG8_LAS bf16x8*)(lds + PG8_SA(b, h) + aoff + m * 2048 + k * 1024); } while (0)
#define PG8_LDB(dst, b, h) do { _Pragma("unroll") for (int n = 0; n < 2; ++n) _Pragma("unroll") for (int k = 0; k < 2; ++k) dst[n][k] = *(const PG8_LAS bf16x8*)(lds + PG8_SB(b, h) + boff + n * 2048 + k * 1024); } while (0)
#define PG8_MMA(ai, bj, At, Bt) do { __builtin_amdgcn_s_setprio(1); _Pragma("unroll") for (int m = 0; m < 4; ++m) _Pragma("unroll") for (int n = 0; n < 2; ++n) _Pragma("unroll") for (int k = 0; k < 2; ++k) \
        acc[ai][bj][m][n] = __builtin_amdgcn_mfma_f32_16x16x32_bf16(Bt[n][k], At[m][k], acc[ai][bj][m][n], 0, 0, 0); __builtin_amdgcn_s_setprio(0); } while (0)
#define PG8_WAIT_V(n) asm volatile("s_waitcnt vmcnt(" #n ")" ::: "memory")
#define PG8_WAIT_L(n) asm volatile("s_waitcnt lgkmcnt(" #n ")" ::: "memory")
#define PG8_BAR __builtin_amdgcn_s_barrier()
#define PG8_SCHED __builtin_amdgcn_sched_barrier(0)
#define PG8_ACOL(u) ((size_t)(((u).pn < g.pn_split) ? g.acol_lo : g.acol_hi) * 2)
    Unit cur, nxt; int ui = 0;
    if (!S.next(0, cur)) return;
    f32x4 acc[2][2][4][2];
#pragma unroll
    for (int a = 0; a < 2; ++a)
#pragma unroll
        for (int b = 0; b < 2; ++b)
#pragma unroll
            for (int m = 0; m < 4; ++m)
#pragma unroll
                for (int n = 0; n < 2; ++n) acc[a][b][m][n] = (f32x4){0.f, 0.f, 0.f, 0.f};
    bf16x8 At[4][2], B0[2][2], B1[2][2];
    const char* cA = (const char*)g.A + (size_t)cur.pm * tstepA + PG8_ACOL(cur); const char* cB = (const char*)g.Bt + (size_t)cur.pn * tstepB;
    S.a_ready(cur);
    if constexpr (SP2) {
        PG8_STAGE(PG8_SB(0, 0), cB, voffB); PG8_STAGE(PG8_SB(0, 1), cB + hstepB, voffB); PG8_STAGE(PG8_SA(0, 0), cA, voffA); PG8_STAGE(PG8_SA(0, 1), cA + hstepA, voffA);
        if (wr == 1) PG8_BAR;
        PG8_WAIT_V(2); PG8_BAR;
        PG8_STAGE(PG8_SB(1, 0), cB + kstep, voffB); PG8_STAGE(PG8_SA(1, 0), cA + kstep, voffA); PG8_STAGE(PG8_SB(1, 1), cB + hstepB + kstep, voffB);
        PG8_WAIT_V(6); PG8_BAR;
    } else {
        PG8_STAGE(PG8_SB(0, 0), cB, voffB); PG8_STAGE(PG8_SA(0, 0), cA, voffA); PG8_STAGE(PG8_SB(0, 1), cB + hstepB, voffB); PG8_STAGE(PG8_SA(0, 1), cA + hstepA, voffA);
        if (wr == 1) PG8_BAR;
        PG8_WAIT_V(4); PG8_BAR;
        PG8_STAGE(PG8_SB(1, 0), cB + kstep, voffB); PG8_STAGE(PG8_SA(1, 0), cA + kstep, voffA); PG8_STAGE(PG8_SB(1, 1), cB + hstepB + kstep, voffB);
        PG8_WAIT_V(6); PG8_BAR;
    }
    for (;;) {
        const bool has_next = S.next(ui + 1, nxt);
        const char* nA = has_next ? (const char*)g.A + (size_t)nxt.pm * tstepA + PG8_ACOL(nxt) : cA; const char* nB = has_next ? (const char*)g.Bt + (size_t)nxt.pn * tstepB : cB;
        for (int t = 0; t < nt; t += 2) {
            const bool last = (t == nt - 2);
            const char* a1 = cA + (size_t)(t + 1) * kstep;
            const char* a2 = last ? nA : cA + (size_t)(t + 2) * kstep; const char* b2 = last ? nB : cB + (size_t)(t + 2) * kstep;
            const char* a3 = a2 + kstep; const char* b3 = b2 + kstep;
            if (last && has_next) S.a_ready(nxt);
            if constexpr (SP2) {
            PG8_LDB(B0, 0, 0); PG8_LDB(B1, 0, 1); PG8_SCHED; PG8_LDA(At, 0, 0); PG8_STAGE(PG8_SA(1, 1), a1 + hstepA, voffA);
            PG8_WAIT_V(8); PG8_WAIT_L(0); PG8_BAR; PG8_MMA(0, 0, At, B0); PG8_MMA(0, 1, At, B1); PG8_BAR; PG8_SCHED;
            PG8_LDA(At, 0, 1); PG8_STAGE(PG8_SB(0, 0), b2, voffB); PG8_STAGE(PG8_SB(0, 1), b2 + hstepB, voffB); PG8_STAGE(PG8_SA(0, 0), a2, voffA);
            PG8_WAIT_V(8); PG8_WAIT_L(0); PG8_BAR; PG8_MMA(1, 0, At, B0); PG8_MMA(1, 1, At, B1); PG8_BAR; PG8_SCHED;
            PG8_LDB(B0, 1, 0); PG8_LDB(B1, 1, 1); PG8_SCHED; PG8_LDA(At, 1, 0); PG8_STAGE(PG8_SA(0, 1), a2 + hstepA, voffA);
            PG8_WAIT_V(8); PG8_WAIT_L(0); PG8_BAR; PG8_MMA(0, 0, At, B0); PG8_MMA(0, 1, At, B1); PG8_BAR; PG8_SCHED;
            PG8_LDA(At, 1, 1); PG8_STAGE(PG8_SB(1, 0), b3, voffB); PG8_STAGE(PG8_SB(1, 1), b3 + hstepB, voffB); PG8_STAGE(PG8_SA(1, 0), a3, voffA);
            PG8_WAIT_V(8); PG8_WAIT_L(0); PG8_BAR; PG8_MMA(1, 0, At, B0); PG8_MMA(1, 1, At, B1); PG8_BAR; PG8_SCHED;
            } else {
            PG8_LDB(B0, 0, 0); PG8_SCHED; PG8_LDA(At, 0, 0); PG8_STAGE(PG8_SA(1, 1), a1 + hstepA, voffA);
            PG8_WAIT_L(8); PG8_BAR; PG8_WAIT_L(0); PG8_MMA(0, 0, At, B0); PG8_BAR; PG8_SCHED;
            PG8_LDB(B1, 0, 1); PG8_STAGE(PG8_SB(0, 0), b2, voffB);
            PG8_BAR; PG8_WAIT_L(0); PG8_MMA(0, 1, At, B1); PG8_BAR;
            PG8_LDA(At, 0, 1); PG8_STAGE(PG8_SA(0, 0), a2, voffA);
            PG8_BAR; PG8_WAIT_L(0); PG8_MMA(1, 0, At, B0); PG8_BAR; PG8_SCHED;
            PG8_STAGE(PG8_SB(0, 1), b2 + hstepB, voffB);
            PG8_WAIT_V(6); PG8_BAR; PG8_MMA(1, 1, At, B1); PG8_BAR;
            PG8_LDB(B0, 1, 0); PG8_SCHED; PG8_LDA(At, 1, 0); PG8_STAGE(PG8_SA(0, 1), a2 + hstepA, voffA);
            PG8_WAIT_L(8); PG8_BAR; PG8_WAIT_L(0); PG8_MMA(0, 0, At, B0); PG8_BAR; PG8_SCHED;
            PG8_LDB(B1, 1, 1); PG8_STAGE(PG8_SB(1, 0), b3, voffB);
            PG8_BAR; PG8_WAIT_L(0); PG8_MMA(0, 1, At, B1); PG8_BAR;
            PG8_LDA(At, 1, 1); PG8_STAGE(PG8_SA(1, 0), a3, voffA);
            PG8_BAR; PG8_WAIT_L(0); PG8_MMA(1, 0, At, B0); PG8_BAR; PG8_SCHED;
            PG8_STAGE(PG8_SB(1, 1), b3 + hstepB, voffB);
            PG8_WAIT_V(6); PG8_BAR; PG8_MMA(1, 1, At, B1); PG8_BAR;
            }
        }
        if constexpr (ALIGN_EPI) { if (wr == 0) PG8_BAR; }
        { const int l2_ = lane_id(); E(acc, cur, wr, wc, l2_ & 15, l2_ >> 4); } S.done(cur);
        if (!has_next) break;
#pragma unroll
        for (int a = 0; a < 2; ++a)
#pragma unroll
            for (int b = 0; b < 2; ++b)
#pragma unroll
                for (int m = 0; m < 4; ++m)
#pragma unroll
                    for (int n = 0; n < 2; ++n) acc[a][b][m][n] = (f32x4){0.f, 0.f, 0.f, 0.f};
        cur = nxt; cA = nA; cB = nB; ++ui;
        if constexpr (ALIGN_EPI) { if (wr == 1) PG8_BAR; }
    }
    PG8_WAIT_V(0);
    if constexpr (!ALIGN_EPI) { if (wr == 0) PG8_BAR; }
    PG8_BAR;
#undef PG8_SA
#undef PG8_SB
#undef PG8_STAGE
#undef PG8_LDA
#undef PG8_LDB
#undef PG8_MMA
#undef PG8_ACOL
}
#define EPI_BAR() do { asm volatile("s_waitcnt lgkmcnt(0)" ::: "memory"); __builtin_amdgcn_s_barrier(); asm volatile("" ::: "memory"); } while (0)

#define EPI_FENCE() asm volatile("" ::: "memory")
__device__ __forceinline__ void rope_rows(f32x4 (&a)[2][2][4][2], int bj, const float* cs, int row0, int fq) {
#pragma unroll
    for (int ai = 0; ai < 2; ++ai)
#pragma unroll
        for (int m = 0; m < 4; ++m) { const float* cr = cs + (size_t)(row0 + ai * HALF + m * 16) * 32 + 8 * (fq & 1);
            const f32x4 c0 = *(const f32x4*)(cr), c1 = *(const f32x4*)(cr + 4), s0 = *(const f32x4*)(cr + 16), s1 = *(const f32x4*)(cr + 20);
            f32x4 v0 = a[ai][bj][m][0], v1 = a[ai][bj][m][1], p0, p1;
#pragma unroll
            for (int j = 0; j < 4; ++j) { p0[j] = __shfl_xor(v0[j], 32); p1[j] = __shfl_xor(v1[j], 32); }
            a[ai][bj][m][0] = (fq < 2) ? (v0 * c0 - p0 * s0) : (v0 * c0 + p0 * s0);
            a[ai][bj][m][1] = (fq < 2) ? (v1 * c1 - p1 * s1) : (v1 * c1 + p1 * s1);
            EPI_FENCE(); }
}
__device__ __forceinline__ void store_rows_bf16(const f32x4 (&acc)[2][2][4][2], bf16_t* base, int ld, int row0, int col0) {
#pragma unroll
    for (int ai = 0; ai < 2; ++ai)
#pragma unroll
        for (int m = 0; m < 4; ++m) { bf16_t* rowp = base + (size_t)(row0 + ai * HALF + m * 16) * ld + col0;
#pragma unroll
            for (int bj = 0; bj < 2; ++bj) { const f32x4 v0 = acc[ai][bj][m][0], v1 = acc[ai][bj][m][1];
                u32x4 w; w.x = cvt_pk_bf16(v0[0], v0[1]); w.y = cvt_pk_bf16(v0[2], v0[3]); w.z = cvt_pk_bf16(v1[0], v1[1]); w.w = cvt_pk_bf16(v1[2], v1[3]);
                *(u32x4*)(rowp + bj * HALF) = w; } }
}
struct EpiInProj {
    static constexpr bool PERM = true;
    bf16_t* proj; const float* ssq; float* dtb; const float* cs; const float* dt_bias; PG8_LAS float* xch; PG8_LAS float* rsl; int pm_cached;
    __device__ __forceinline__ void operator()(f32x4 (&acc)[2][2][4][2], const Unit& u, int wr, int wc, int fr, int fq) const {
        const int row0 = u.pm * BM + wr * 64 + fr;
        if (u.pm == pm_cached) {
#pragma unroll
            for (int ai = 0; ai < 2; ++ai)
#pragma unroll
                for (int m = 0; m < 4; ++m) { const float rs = rsl[ai * HALF + wr * 64 + m * 16 + fr];
#pragma unroll
                    for (int bj = 0; bj < 2; ++bj)
#pragma unroll
                        for (int n = 0; n < 2; ++n) acc[ai][bj][m][n] = acc[ai][bj][m][n] * rs; }
        } else {
#pragma unroll
            for (int ai = 0; ai < 2; ++ai)
#pragma unroll
                for (int m = 0; m < 4; ++m) { const int r = row0 + ai * HALF + m * 16;
                    const float s = (ssq[r] + ssq[T + r]) + (ssq[2 * T + r] + ssq[3 * T + r]); const float rs = 1.0f / sqrtf(s * (1.0f / DM) + NORM_EPS);
#pragma unroll
                    for (int bj = 0; bj < 2; ++bj)
#pragma unroll
                        for (int n = 0; n < 2; ++n) acc[ai][bj][m][n] = acc[ai][bj][m][n] * rs;
                    EPI_FENCE(); }
        }
        if (u.pn >= 11) {
            const bool t11 = (u.pn == 11);
#pragma unroll
            for (int ai = 0; ai < 2; ++ai)
#pragma unroll
                for (int m = 0; m < 4; ++m) { float s = 0.f;
#pragma unroll
                    for (int n = 0; n < 2; ++n) { const f32x4 x = acc[ai][0][m][n]; s += (x[0] * x[0] + x[1] * x[1]) + (x[2] * x[2] + x[3] * x[3]); }
                    if (t11) {
#pragma unroll
                        for (int n = 0; n < 2; ++n) { const f32x4 x = acc[ai][1][m][n]; s += (x[0] * x[0] + x[1] * x[1]) + (x[2] * x[2] + x[3] * x[3]); } }
                    s += __shfl_xor(s, 16); s += __shfl_xor(s, 32);
                    if (fq == 0) xch[(ai * HALF + wr * 64 + m * 16 + fr) * 4 + wc] = s; }
            EPI_BAR();
#pragma unroll
            for (int ai = 0; ai < 2; ++ai)
#pragma unroll
                for (int m = 0; m < 4; ++m) { const f32x4 p = *(const PG8_LAS f32x4*)(xch + (ai * HALF + wr * 64 + m * 16 + fr) * 4);
                    const float tot = (p[0] + p[1]) + (p[2] + p[3]); const float rn = 1.0f / sqrtf(tot * (t11 ? (1.0f / 256.f) : (1.0f / 128.f)) + NORM_EPS);
#pragma unroll
                    for (int n = 0; n < 2; ++n) { acc[ai][0][m][n] = acc[ai][0][m][n] * rn; if (t11) acc[ai][1][m][n] = acc[ai][1][m][n] * rn; } }
            EPI_BAR();
            if (!t11) {
                if (wc == 0) rope_rows(acc, 1, cs, row0, fq);
                else if (wc == 1 && fq == 0) {
#pragma unroll
                    for (int ai = 0; ai < 2; ++ai)
#pragma unroll
                        for (int m = 0; m < 4; ++m) { const int r = row0 + ai * HALF + m * 16; const f32x4 a0 = acc[ai][1][m][0], a1 = acc[ai][1][m][1];
                            *(f32x4*)(dtb + (size_t)r * 8) = a0; *(f32x4*)(dtb + (size_t)r * 8 + 4) = a1; }
                }
            }
        }
        store_rows_bf16(acc, proj, NP, row0, u.pn * BM + wc * 32 + 8 * fq);
    }
};
struct EpiQKV {
    static constexpr bool PERM = true;
    bf16_t* qkv; const float* cs;
    __device__ __forceinline__ void operator()(f32x4 (&acc)[2][2][4][2], const Unit& u, int wr, int wc, int fr, int fq) const {
        const int row0 = u.pm * BM + wr * 64 + fr;
#pragma unroll
        for (int bj = 0; bj < 2; ++bj) { const int cb = u.pn * BM + bj * HALF + wc * 32;
            if (cb >= QC_QR && cb < QC_QR + 192) rope_rows(acc, bj, cs, row0, fq); }
        store_rows_bf16(acc, qkv, NQKV, row0, u.pn * BM + wc * 32 + 8 * fq);
    }
};
struct EpiOut {
    static constexpr bool PERM = false;
    const float* base; float* xo; bf16_t* xb; float* ssq; PG8_LAS float* xch;
    __device__ __forceinline__ void operator()(f32x4 (&acc)[2][2][4][2], const Unit& u, int wr, int wc, int fr, int fq) const {
        const int row0 = u.pm * BM + wr * 64 + fr, col0 = u.pn * BM + wc * 32 + 4 * fq;
#pragma unroll
        for (int ai = 0; ai < 2; ++ai)
#pragma unroll
            for (int m = 0; m < 4; ++m) { const size_t off = (size_t)(row0 + ai * HALF + m * 16) * DM + col0; float s = 0.f;
#pragma unroll
                for (int bj = 0; bj < 2; ++bj)
#pragma unroll
                    for (int n = 0; n < 2; ++n) { const f32x4 v = *(const f32x4*)(base + off + bj * HALF + n * 16) + acc[ai][bj][m][n];
                        *(f32x4*)(xo + off + bj * HALF + n * 16) = v; s += (v[0] * v[0] + v[1] * v[1]) + (v[2] * v[2] + v[3] * v[3]);
                        if (xb) { u32x2 w; w.x = cvt_pk_bf16(v[0], v[1]); w.y = cvt_pk_bf16(v[2], v[3]); *(u32x2*)(xb + off + bj * HALF + n * 16) = w; } }
                s += __shfl_xor(s, 16); s += __shfl_xor(s, 32);
                if (fq == 0) xch[(ai * HALF + wr * 64 + m * 16 + fr) * 4 + wc] = s; }
        EPI_BAR();
        const int tid_ = (wr * 4 + wc) * 64 + fq * 16 + fr;
        if (tid_ < 256) { const f32x4 p = *(const PG8_LAS f32x4*)(xch + tid_ * 4); ssq[(size_t)u.pn * T + u.pm * BM + tid_] = (p[0] + p[1]) + (p[2] + p[3]); }
        EPI_BAR();
    }
};
}

__device__ __forceinline__ void p1_inproj(Frame& F, KArgs a, int l) {
    FRAME_IDS;
    pg8::Gemm g{(const bf16*)(F.dout + DO_XB), (const bf16*)(F.ws + WS_WIN) + (size_t)l * NP * DM, DM, DM, DM, 0, 0, 0};
    pg8::StaticOrder S; S.init(T, NP, F.G, F.bid);
    LAS float* rsl = (LAS float*)(F.lds + XCH_OFF + 4096); const float* ssq = (const float*)(F.ws + WS_SSQ);
    pg8::Unit u0; int pm0 = -1;
    if (S.next(0, u0)) { pm0 = u0.pm;
        if (tid < 256) { const int r = pm0 * 256 + tid; const float s = (ssq[r] + ssq[T + r]) + (ssq[2 * T + r] + ssq[3 * T + r]); rsl[tid] = 1.0f / sqrtf(s * (1.0f / DM) + NORM_EPS); } }
    __syncthreads();
    pg8::EpiInProj E{(bf16*)(F.ws + WS_PROJ), ssq, (float*)(F.ws + WS_DT), (const float*)(F.ws + WS_CS), a->ssd_dt_bias + l * 6, (LAS float*)(F.lds + XCH_OFF), rsl, pm0};
    pg8::gemm_phase<pg8::EpiInProj, pg8::StaticOrder, true, true>(F.lds, g, S, E, F.wave, lane_id());
}
__device__ __forceinline__ void p2_qkv(Frame& F, int l) {
    pg8::Gemm g{(const bf16*)(F.ws + WS_PROJ), (const bf16*)(F.ws + WS_WQKV) + (size_t)l * NQKV * 256, NP, 256, 256, PC_QA, PC_KV, 3};
    pg8::StaticOrder S; S.init(T, NQKV, F.G, F.bid);
    pg8::EpiQKV E{(bf16*)(F.dout + DO_QKV), (const float*)(F.ws + WS_CS)};
    pg8::gemm_phase<pg8::EpiQKV, pg8::StaticOrder, true, true>(F.lds, g, S, E, F.wave, lane_id());
}
__device__ __forceinline__ void p4_outproj(Frame& F, KArgs a, int l) {
    pg8::Gemm g{(const bf16*)(F.ws + WS_Y), (const bf16*)(F.ws + WS_WOUT) + (size_t)l * DM * DM, DM, DM, DM, 0, 0, 0};
    pg8::StaticOrder S; S.init(T, DM, F.G, F.bid);
    pg8::EpiOut E{l == 0 ? a->x : (const float*)(F.ws + WS_XRES), l == 0 ? (float*)(F.ws + WS_XRES) : a->out, l == 0 ? (bf16*)(F.dout + DO_XB) : (bf16*)nullptr, (float*)(F.ws + WS_SSQ), (LAS float*)(F.lds + XCH_OFF)};
    pg8::gemm_phase<pg8::EpiOut, pg8::StaticOrder, true, true>(F.lds, g, S, E, F.wave, lane_id());
}

__device__ __forceinline__ void p2_conva(Frame& F, KArgs a, int l) {
    FRAME_IDS;
    const bf16* proj = (const bf16*)(F.ws + WS_PROJ); bf16* y = (bf16*)(F.ws + WS_Y); const float* cw = a->conv_a_w + (size_t)l * 3 * 256;
    const size_t total = (size_t)T * 256;
    for (size_t e = (size_t)F.bid * NTHR + tid; e < total; e += (size_t)F.G * NTHR) {
        const int r = (int)(e >> 8), c = (int)(e & 255), s = r % SEQ;
        float conv = 0.f;
#pragma unroll
        for (int k = 0; k < 3; ++k) { const int ds = s - 2 + k; if (ds >= 0) { const bf16* pr = proj + (size_t)(r - 2 + k) * NP; conv += cw[k * 256 + c] * (bf2f(pr[PC_AC + c]) * bf2f(pr[PC_AH + c])); } }
        const bf16* pr = proj + (size_t)r * NP;
        y[(size_t)r * DM + YC_A + c] = (bf16)f2bf(bf2f(pr[PC_AB + c]) * conv * silu_f(bf2f(pr[PC_AZ + c])));
    }
}

namespace att {
typedef float f32x16 __attribute__((ext_vector_type(16)));
typedef short s16x4 __attribute__((ext_vector_type(4)));
typedef short v4i16_t __attribute__((ext_vector_type(4)));
constexpr int KSLOT = 12288, VSLOT = 8192, NSLOT = 3;
constexpr int LDS_K = 0, LDS_V = NSLOT * KSLOT, LDS_WS = LDS_V + NSLOT * VSLOT, LDS_END = LDS_WS + NWAVES * 64 * 4;
static_assert(LDS_END <= RING_BYTES, "attention LDS");
__device__ __forceinline__ int crow(int r, int hi) { return (r & 3) + 8 * (r >> 2) + 4 * hi; }
__device__ __forceinline__ void glds16(const void* gsrc, unsigned lds_dst) { unsigned keep;
    asm volatile("s_mov_b32 %0, m0\n\ts_mov_b32 m0, %2\n\ts_nop 0\n\tglobal_load_lds_dwordx4 %1, off\n\ts_mov_b32 m0, %0" : "=&s"(keep) : "v"(gsrc), "s"(lds_dst) : "memory"); }
__device__ __forceinline__ s16x4 vtr(const LAS unsigned char* p) { return __builtin_bit_cast(s16x4, __builtin_amdgcn_ds_read_tr16_b64_v4i16((LAS v4i16_t*)p)); }
__device__ __forceinline__ unsigned cvtpk(float lo, float hi) { unsigned r; asm volatile("v_cvt_pk_bf16_f32 %0, %1, %2" : "=v"(r) : "v"(lo), "v"(hi)); return r; }

__device__ __forceinline__ void attn_unit(int b, int h, int qb, const bf16* qkv, const bf16* proj, bf16* y, LAS unsigned char* lds, int wid, int lane) {
    const int r32 = lane & 31, hi = lane >> 5;
    const size_t rowbase = (size_t)b * SEQ; const int q0 = qb * 256, NT = 4 * (qb + 1);
    const bf16* qrow = qkv + (rowbase + q0 + wid * 32 + r32) * NQKV;
    bf16x8 qr[6];
#pragma unroll
    for (int d0 = 0; d0 < 4; ++d0) qr[d0] = *(const GAS bf16x8*)(qrow + QC_QN + h * 64 + d0 * 16 + hi * 8);
#pragma unroll
    for (int d0 = 0; d0 < 2; ++d0) qr[4 + d0] = *(const GAS bf16x8*)(qrow + QC_QR + h * 32 + d0 * 16 + hi * 8);
    asm volatile("s_waitcnt vmcnt(0)" : "+v"(qr[0]), "+v"(qr[1]), "+v"(qr[2]), "+v"(qr[3]), "+v"(qr[4]), "+v"(qr[5]) :: "memory");
    const unsigned lds0 = (unsigned)(unsigned long)lds;
    const bf16* ksrc = qkv + (rowbase + lane) * NQKV + QC_KN + h * 64 + wid * 8;
    const bf16* rsrc = proj + (rowbase + lane) * NP + PC_KR + (wid & 3) * 8;
    const bf16* vsrc = qkv + (rowbase + 16 * (wid & 3) + (lane >> 2)) * NQKV + QC_V + h * 64 + (wid >> 2) * 32 + (lane & 3) * 8;
#define ATT_ISSUE(t, slot) do { \
        glds16(ksrc + (size_t)(t) * 64 * NQKV, (unsigned)__builtin_amdgcn_readfirstlane(lds0 + LDS_K + (slot) * KSLOT + wid * 1024)); \
        glds16(vsrc + (size_t)(t) * 64 * NQKV, (unsigned)__builtin_amdgcn_readfirstlane(lds0 + LDS_V + (slot) * VSLOT + wid * 1024)); \
        if (wid < 4) glds16(rsrc + (size_t)(t) * 64 * NP, (unsigned)__builtin_amdgcn_readfirstlane(lds0 + LDS_K + (slot) * KSLOT + (8 + wid) * 1024)); } while (0)
    LAS float* wsf = (LAS float*)(lds + LDS_WS) + wid * 64;
    f32x16 o[2]; o[0] = f32x16{}; o[1] = f32x16{};
    float mrow = -INFINITY, lsum = 0.f;
    ATT_ISSUE(0, 0); ATT_ISSUE(1, 1);
    int slot = 0;
    for (int t = 0; t < NT; ++t) {
        if (t + 1 < NT) { if (wid < 4) asm volatile("s_waitcnt vmcnt(3)" ::: "memory"); else asm volatile("s_waitcnt vmcnt(2)" ::: "memory"); }
        else asm volatile("s_waitcnt vmcnt(0)" ::: "memory");
        asm volatile("s_barrier" ::: "memory");
        if (t + 2 < NT) { const int s2 = slot == 0 ? 2 : slot - 1; ATT_ISSUE(t + 2, s2); }
        const int jb = t - (NT - 4);
        if (!(jb >= 0 && 64 * jb > 32 * wid + 31)) {
            const LAS unsigned char* Kb = lds + LDS_K + slot * KSLOT + hi * 1024 + r32 * 16;
            f32x16 p0 = f32x16{}, p1 = f32x16{};
#pragma unroll
            for (int d0 = 0; d0 < 6; ++d0) {
                const bf16x8 k0 = *(const LAS bf16x8*)(Kb + d0 * 2048), k1 = *(const LAS bf16x8*)(Kb + d0 * 2048 + 512);
                p0 = __builtin_amdgcn_mfma_f32_32x32x16_bf16(k0, qr[d0], p0, 0, 0, 0);
                p1 = __builtin_amdgcn_mfma_f32_32x32x16_bf16(k1, qr[d0], p1, 0, 0, 0);
            }
            if (jb >= 0) { const int qrel = wid * 32 + r32, kb = 64 * jb + 4 * hi;
#pragma unroll
                for (int r = 0; r < 16; ++r) { const int kv = kb + (r & 3) + 8 * (r >> 2); if (kv > qrel) p0[r] = -INFINITY; if (kv + 32 > qrel) p1[r] = -INFINITY; } }
            float mx = fmaxf(p0[0], p1[0]);
#pragma unroll
            for (int r = 1; r < 16; ++r) mx = fmaxf(mx, fmaxf(p0[r], p1[r]));
            mx = fmaxf(mx, __shfl_xor(mx, 32));
            const float mnew = fmaxf(mrow, mx);
            if (__any(mnew != mrow)) {
                const float f = exp2f(mrow - mnew);
                lsum *= f; if (hi == 0) wsf[r32] = f;
#pragma unroll
                for (int g = 0; g < 4; ++g) { const f32x4 fv = *(const LAS f32x4*)(wsf + 8 * g + 4 * hi);
#pragma unroll
                    for (int j = 0; j < 4; ++j) { o[0][4 * g + j] *= fv[j]; o[1][4 * g + j] *= fv[j]; } }
                mrow = mnew;
            }
            float sacc = 0.f;
#pragma unroll
            for (int r = 0; r < 16; ++r) { p0[r] = exp2f(p0[r] - mrow); p1[r] = exp2f(p1[r] - mrow); sacc += p0[r] + p1[r]; }
            lsum += sacc;
            v4u pw[4];
#pragma unroll
            for (int i = 0; i < 4; ++i) { pw[0][i] = cvtpk(p0[2 * i], p0[2 * i + 1]); pw[1][i] = cvtpk(p0[8 + 2 * i], p0[8 + 2 * i + 1]); pw[2][i] = cvtpk(p1[2 * i], p1[2 * i + 1]); pw[3][i] = cvtpk(p1[8 + 2 * i], p1[8 + 2 * i + 1]); }
            const LAS unsigned char* vp = lds + LDS_V + slot * VSLOT + ((lane >> 4) & 1) * 32 + (lane & 3) * 8 + (4 * hi + ((lane & 15) >> 2)) * 64;
#pragma unroll
            for (int d0 = 0; d0 < 2; ++d0)
#pragma unroll
                for (int ks = 0; ks < 4; ++ks) { const s16x4 lo = vtr(vp + d0 * 4096 + ks * 1024), hh = vtr(vp + d0 * 4096 + ks * 1024 + 512);
                    const bf16x8 vf = (bf16x8){lo[0], lo[1], lo[2], lo[3], hh[0], hh[1], hh[2], hh[3]};
                    o[d0] = __builtin_amdgcn_mfma_f32_32x32x16_bf16(__builtin_bit_cast(bf16x8, pw[ks]), vf, o[d0], 0, 0, 0); }
        }
        slot = slot == 2 ? 0 : slot + 1;
    }
#undef ATT_ISSUE
    lsum += __shfl_xor(lsum, 32);
    if (hi == 0) wsf[32 + r32] = lsum;
    bf16* yw = y + (rowbase + q0 + wid * 32 + 4 * hi) * DM + YC_C + h * 64 + r32; const bf16* zw = proj + (rowbase + q0 + wid * 32 + 4 * hi) * NP + PC_CZ + h * 64 + r32;
#pragma unroll
    for (int g = 0; g < 4; ++g) { const f32x4 lv = *(const LAS f32x4*)(wsf + 32 + 8 * g + 4 * hi);
#pragma unroll
        for (int j = 0; j < 4; ++j) { const int r = 4 * g + j; const float inv = 1.0f / lv[j];
#pragma unroll
            for (int d0 = 0; d0 < 2; ++d0) { const float z = bf2f(zw[d0 * 32]); yw[d0 * 32] = (bf16)f2bf(o[d0][r] * inv * silu_f(z)); }
            zw += NP; yw += DM; }
        zw += 4 * NP; yw += 4 * DM; asm volatile("" ::: "memory"); }
    asm volatile("s_waitcnt lgkmcnt(0)\n\ts_barrier" ::: "memory");
}
}
constexpr int N_ATT_UNITS = BATCH * NHEAD * (SEQ / 256);

namespace ssd {
typedef float f32x16 __attribute__((ext_vector_type(16)));
constexpr int PIT = 136;
constexpr int L_BN = 0, L_CN = 34816, L_XT = 69632, L_ACS = 121856, L_DT = 123392, L_W = 124928, L_SQ = 126464, L_END = 127488;
static_assert(L_END <= RING_BYTES, "ssd LDS");
constexpr int N_UNITS = BATCH * NCHUNK * SSD_G;
__device__ __forceinline__ int crow(int r, int hi) { return (r & 3) + 8 * (r >> 2) + 4 * hi; }
__device__ __forceinline__ unsigned cvtpk(float lo, float hi) { unsigned r; asm volatile("v_cvt_pk_bf16_f32 %0, %1, %2" : "=v"(r) : "v"(lo), "v"(hi)); return r; }
__device__ __forceinline__ float bfe(const v4u& v, int j) { const unsigned w = v[j >> 1]; return (j & 1) ? bfhi(w) : bflo(w); }

__device__ __forceinline__ void dt_acs(const float* dtb, const float* dt_bias, const float* a_log, size_t t0, int g, LAS unsigned char* lds, bool want_w, float* cdec_out, int wid, int lane) {
    if (wid < 3) {
        const int h = 3 * g + wid; const float A = -__expf(a_log[h]), bias = dt_bias[h];
        const int l0 = 2 * lane;
        const float d0 = softplus_f(dtb[(t0 + l0) * 8 + h] + bias), d1 = softplus_f(dtb[(t0 + l0 + 1) * 8 + h] + bias);
        const float la0 = d0 * A, pair = la0 + d1 * A;
        float v = pair;
#pragma unroll
        for (int off = 1; off < 64; off <<= 1) { const float t = __shfl_up(v, off); if (lane >= off) v += t; }
        const float a0 = (v - pair) + la0, a1 = v, total = __shfl(v, 63);
        LAS float* acs = (LAS float*)(lds + L_ACS) + wid * 128; LAS float* dts = (LAS float*)(lds + L_DT) + wid * 128;
        acs[l0] = a0; acs[l0 + 1] = a1; dts[l0] = d0; dts[l0 + 1] = d1;
        if (want_w) { LAS float* w = (LAS float*)(lds + L_W) + wid * 128; w[l0] = d0 * __expf(total - a0); w[l0 + 1] = d1 * __expf(total - a1); }
        if (cdec_out && lane == 0) cdec_out[h] = __expf(total);
    }
}
template <bool PASS2>
__device__ __forceinline__ void conv_stage(const bf16* proj, const float* cw, const float* cb, int b, int c, int g, LAS unsigned char* lds, int tid) {
    const int co = tid >> 3, tg = tid & 7;
    if (co >= (PASS2 ? 56 : 40)) return;
    const int kind = co < 24 ? 0 : (co < 40 ? 1 : 2);
    const int pc = kind == 0 ? PC_SX + g * 192 + co * 8 : (kind == 1 ? PC_SB + g * 128 + (co - 24) * 8 : PC_SC + g * 128 + (co - 40) * 8);
    const int wc = kind == 0 ? g * 192 + co * 8 : (kind == 1 ? 384 + g * 128 + (co - 24) * 8 : 640 + g * 128 + (co - 40) * 8);
    float w[4][8], bs[8];
#pragma unroll
    for (int k = 0; k < 4; ++k) { const f32x4 a = *(const f32x4*)(cw + k * 896 + wc), bb = *(const f32x4*)(cw + k * 896 + wc + 4);
#pragma unroll
        for (int j = 0; j < 4; ++j) { w[k][j] = a[j]; w[k][4 + j] = bb[j]; } }
    { const f32x4 a = *(const f32x4*)(cb + wc), bb = *(const f32x4*)(cb + wc + 4);
#pragma unroll
      for (int j = 0; j < 4; ++j) { bs[j] = a[j]; bs[4 + j] = bb[j]; } }
    const int l0 = tg * 16, seq0 = c * CHUNK + l0 - 3;
    const bf16* src = proj + ((long)b * SEQ + seq0) * NP + pc;
    v4u raw[19];
#pragma unroll
    for (int i = 0; i < 19; ++i) raw[i] = (seq0 + i >= 0) ? *(const GAS v4u*)(src + (long)i * NP) : (v4u){0u, 0u, 0u, 0u};
    if (kind == 0 || !PASS2) {
        LAS unsigned char* base = lds + (kind == 0 ? L_XT + (co * 8) * PIT * 2 : L_BN + ((co - 24) * 8) * PIT * 2) + l0 * 2;
        const LAS float* wts = (const LAS float*)(lds + L_W) + (co >> 3) * 128 + l0;
#pragma unroll
        for (int j = 0; j < 8; ++j) { unsigned pk[8];
#pragma unroll
            for (int ip = 0; ip < 8; ++ip) { float o0 = bs[j], o1 = bs[j];
#pragma unroll
                for (int k = 0; k < 4; ++k) { o0 = fmaf(w[k][j], bfe(raw[2 * ip + k], j), o0); o1 = fmaf(w[k][j], bfe(raw[2 * ip + 1 + k], j), o1); }
                o0 = silu_f(o0); o1 = silu_f(o1);
                if (!PASS2 && kind == 0) { o0 *= wts[2 * ip]; o1 *= wts[2 * ip + 1]; }
                pk[ip] = cvtpk(o0, o1); }
            *(LAS v4u*)(base + j * PIT * 2) = (v4u){pk[0], pk[1], pk[2], pk[3]}; *(LAS v4u*)(base + j * PIT * 2 + 16) = (v4u){pk[4], pk[5], pk[6], pk[7]}; }
    } else {
        LAS unsigned char* base = lds + (kind == 1 ? L_BN + (co - 24) * 16 : L_CN + (co - 40) * 16) + l0 * PIT * 2;
#pragma unroll
        for (int i = 0; i < 16; ++i) { float o[8];
#pragma unroll
            for (int j = 0; j < 8; ++j) { float a = bs[j];
#pragma unroll
                for (int k = 0; k < 4; ++k) a = fmaf(w[k][j], bfe(raw[i + k], j), a);
                o[j] = silu_f(a); }
            *(LAS v4u*)(base + i * PIT * 2) = (v4u){cvtpk(o[0], o[1]), cvtpk(o[2], o[3]), cvtpk(o[4], o[5]), cvtpk(o[6], o[7])}; }
    }
}
__device__ __forceinline__ void pass1_unit(int u, KArgs a, int layer, unsigned char* ws, LAS unsigned char* lds, int wid, int lane) {
    const int g = u % SSD_G, c = (u / SSD_G) % NCHUNK, b = u / (SSD_G * NCHUNK); const size_t t0 = (size_t)b * SEQ + (size_t)c * CHUNK;
    const int tid = wid * 64 + lane, r32 = lane & 31, hi = lane >> 5;
    float* cdec = (float*)(ws + WS_CDEC) + ((size_t)b * NCHUNK + c) * 8;
    dt_acs((const float*)(ws + WS_DT), a->ssd_dt_bias + layer * 6, a->ssd_a_log + layer * 6, t0, g, lds, true, cdec, wid, lane);
    __syncthreads();
    conv_stage<false>((const bf16*)(ws + WS_PROJ), a->ssd_conv_w + (size_t)layer * 4 * 896, a->ssd_conv_b + (size_t)layer * 896, b, c, g, lds, tid);
    __syncthreads();
    float* st = (float*)(ws + WS_ST) + (((size_t)b * NCHUNK + c) * 6 + 3 * g) * (SSD_P * SSD_N);
#pragma unroll
    for (int i = 0; i < 3; ++i) { const int idx = wid + 8 * i, hh = idx >> 3, pt = (idx & 7) >> 2, nt = idx & 3;
        const LAS unsigned char* ap = lds + L_XT + (hh * 64 + pt * 32 + r32) * PIT * 2 + hi * 16; const LAS unsigned char* bp = lds + L_BN + (nt * 32 + r32) * PIT * 2 + hi * 16;
        f32x16 acc = f32x16{};
#pragma unroll
        for (int kk = 0; kk < 8; ++kk) acc = __builtin_amdgcn_mfma_f32_32x32x16_bf16(*(const LAS bf16x8*)(ap + kk * 32), *(const LAS bf16x8*)(bp + kk * 32), acc, 0, 0, 0);
        float* o = st + (size_t)hh * (SSD_P * SSD_N) + (size_t)(pt * 32) * SSD_N + nt * 32 + r32;
#pragma unroll
        for (int r = 0; r < 16; ++r) o[(size_t)crow(r, hi) * SSD_N] = acc[r]; }
    __syncthreads();
}
__device__ __forceinline__ void scan_phase(Frame& F) {
    FRAME_IDS;
    float* st = (float*)(F.ws + WS_ST); const float* cdec = (const float*)(F.ws + WS_CDEC);
    constexpr int PER = SSD_P * SSD_N / 4, NITEM = BATCH * SSD_H * PER;
    for (int e = F.bid * NTHR + tid; e < NITEM; e += F.G * NTHR) {
        const int q = e % PER, h = (e / PER) % SSD_H, b = e / (PER * SSD_H);
        f32x4 carry = (f32x4){0.f, 0.f, 0.f, 0.f};
#pragma unroll 4
        for (int c = 0; c < NCHUNK; ++c) { f32x4* p = (f32x4*)(st + (((size_t)b * NCHUNK + c) * 6 + h) * (SSD_P * SSD_N)) + q; const f32x4 s = *p; *p = carry;
            carry = carry * cdec[((size_t)b * NCHUNK + c) * 8 + h] + s; }
    }
}
__device__ __forceinline__ void pass2_unit(int u, KArgs a, int layer, unsigned char* ws, LAS unsigned char* lds, int wid, int lane) {
    const int g = u % SSD_G, c = (u / SSD_G) % NCHUNK, b = u / (SSD_G * NCHUNK); const size_t t0 = (size_t)b * SEQ + (size_t)c * CHUNK;
    const int tid = wid * 64 + lane, r32 = lane & 31, hi = lane >> 5, lt = wid & 3, pt = wid >> 2;
    const bf16* proj = (const bf16*)(ws + WS_PROJ);
    dt_acs((const float*)(ws + WS_DT), a->ssd_dt_bias + layer * 6, a->ssd_a_log + layer * 6, t0, g, lds, false, nullptr, wid, lane);
    conv_stage<true>(proj, a->ssd_conv_w + (size_t)layer * 4 * 896, a->ssd_conv_b + (size_t)layer * 896, b, c, g, lds, tid);
    __syncthreads();
    f32x16 Gt[4];
    const LAS unsigned char* cp = lds + L_CN + (lt * 32 + r32) * PIT * 2 + hi * 16;
#pragma unroll
    for (int st = 0; st < 4; ++st) { Gt[st] = f32x16{};
        if (st <= lt) { const LAS unsigned char* bp = lds + L_BN + (st * 32 + r32) * PIT * 2 + hi * 16;
#pragma unroll
            for (int kk = 0; kk < 8; ++kk) Gt[st] = __builtin_amdgcn_mfma_f32_32x32x16_bf16(*(const LAS bf16x8*)(bp + kk * 32), *(const LAS bf16x8*)(cp + kk * 32), Gt[st], 0, 0, 0); } }
    __syncthreads();
    const float* prevg = (const float*)(ws + WS_ST) + (((size_t)b * NCHUNK + c) * 6 + 3 * g) * (SSD_P * SSD_N);
    float gq[3][16]; float ssq = 0.f;
#pragma unroll
    for (int hh = 0; hh < 3; ++hh) {
        const int h = 3 * g + hh;
        f32x16 yt = f32x16{};
        const LAS float* acs = (const LAS float*)(lds + L_ACS) + hh * 128; const LAS float* dts = (const LAS float*)(lds + L_DT) + hh * 128;
        const float acs_l = acs[lt * 32 + r32];
        if (c > 0) {
            { const float* pr = prevg + (size_t)hh * (SSD_P * SSD_N) + (size_t)(tid >> 3) * SSD_N + (tid & 7) * 16; LAS unsigned char* dst = lds + L_BN + (tid >> 3) * PIT * 2 + (tid & 7) * 32;
              const f32x4 v0 = *(const f32x4*)pr, v1 = *(const f32x4*)(pr + 4), v2 = *(const f32x4*)(pr + 8), v3 = *(const f32x4*)(pr + 12);
              *(LAS v4u*)dst = (v4u){cvtpk(v0[0], v0[1]), cvtpk(v0[2], v0[3]), cvtpk(v1[0], v1[1]), cvtpk(v1[2], v1[3])};
              *(LAS v4u*)(dst + 16) = (v4u){cvtpk(v2[0], v2[1]), cvtpk(v2[2], v2[3]), cvtpk(v3[0], v3[1]), cvtpk(v3[2], v3[3])}; }
            __syncthreads();
            const LAS unsigned char* pp = lds + L_BN + (pt * 32 + r32) * PIT * 2 + hi * 16;
#pragma unroll
            for (int kk = 0; kk < 8; ++kk) yt = __builtin_amdgcn_mfma_f32_32x32x16_bf16(*(const LAS bf16x8*)(pp + kk * 32), *(const LAS bf16x8*)(cp + kk * 32), yt, 0, 0, 0);
            const float el = __expf(acs_l);
#pragma unroll
            for (int r = 0; r < 16; ++r) yt[r] *= el;
        }
        const float Dk = a->ssd_d[layer * 6 + h];
        const LAS unsigned char* xp = lds + L_XT + (hh * 64 + pt * 32 + r32) * PIT * 2 + hi * 8;
        int r32h = r32; asm volatile("" : "+v"(r32h));
#pragma unroll
        for (int st = 0; st < 4; ++st) if (st <= lt) {
            unsigned mw[8];
            if (st < lt) {
#pragma unroll
                for (int gi = 0; gi < 4; ++gi) { const f32x4 as = *(const LAS f32x4*)(acs + st * 32 + 8 * gi + 4 * hi), ds = *(const LAS f32x4*)(dts + st * 32 + 8 * gi + 4 * hi); float m[4];
#pragma unroll
                    for (int j = 0; j < 4; ++j) m[j] = Gt[st][4 * gi + j] * __expf(acs_l - as[j]) * ds[j];
                    mw[2 * gi] = cvtpk(m[0], m[1]); mw[2 * gi + 1] = cvtpk(m[2], m[3]); }
            } else {
#pragma unroll
                for (int gi = 0; gi < 4; ++gi) { const f32x4 as = *(const LAS f32x4*)(acs + st * 32 + 8 * gi + 4 * hi), ds = *(const LAS f32x4*)(dts + st * 32 + 8 * gi + 4 * hi); float m[4];
#pragma unroll
                    for (int j = 0; j < 4; ++j) { const int dl = r32h - (8 * gi + 4 * hi + j);
                        const float mf = (float)min(max(dl + 1, 0), 1), df = (float)(1 - min(abs(dl), 1));
                        m[j] = Gt[st][4 * gi + j] * __expf(fminf(acs_l - as[j], 0.f)) * ds[j] * mf + Dk * df; }
                    mw[2 * gi] = cvtpk(m[0], m[1]); mw[2 * gi + 1] = cvtpk(m[2], m[3]); }
            }
#pragma unroll
            for (int ks = 0; ks < 2; ++ks) {
                const v2u xa = *(const LAS v2u*)(xp + (st * 32 + ks * 16) * 2), xb2 = *(const LAS v2u*)(xp + (st * 32 + ks * 16 + 8) * 2);
                const v4u af = (v4u){xa.x, xa.y, xb2.x, xb2.y}, bfm = (v4u){mw[4 * ks], mw[4 * ks + 1], mw[4 * ks + 2], mw[4 * ks + 3]};
                yt = __builtin_amdgcn_mfma_f32_32x32x16_bf16(__builtin_bit_cast(bf16x8, af), __builtin_bit_cast(bf16x8, bfm), yt, 0, 0, 0); }
        }
        const bf16* zr = proj + (t0 + lt * 32 + r32) * NP + PC_SZ + h * 64 + pt * 32 + 4 * hi;
#pragma unroll
        for (int gi = 0; gi < 4; ++gi) { const v2u zw = *(const GAS v2u*)(zr + 8 * gi);
            const float z0 = bflo(zw.x), z1 = bfhi(zw.x), z2 = bflo(zw.y), z3 = bfhi(zw.y);
            gq[hh][4 * gi + 0] = yt[4 * gi + 0] * silu_f(z0); gq[hh][4 * gi + 1] = yt[4 * gi + 1] * silu_f(z1); gq[hh][4 * gi + 2] = yt[4 * gi + 2] * silu_f(z2); gq[hh][4 * gi + 3] = yt[4 * gi + 3] * silu_f(z3); }
#pragma unroll
        for (int r = 0; r < 16; ++r) ssq += gq[hh][r] * gq[hh][r];
        if (c > 0) __syncthreads();
    }
    ssq += __shfl_xor(ssq, 32);
    LAS float* sq = (LAS float*)(lds + L_SQ);
    if (hi == 0) sq[pt * 128 + lt * 32 + r32] = ssq;
    __syncthreads();
    const float tot = sq[lt * 32 + r32] + sq[128 + lt * 32 + r32]; const float rn = 1.0f / sqrtf(tot * (1.0f / 192.f) + SSD_NORM_EPS);
    bf16* yo = (bf16*)(ws + WS_Y) + (t0 + lt * 32 + r32) * DM + YC_B + g * 192 + pt * 32 + 4 * hi; const float* ng = a->ssd_norm_g + (size_t)layer * 384 + g * 192 + pt * 32 + 4 * hi;
#pragma unroll
    for (int hh = 0; hh < 3; ++hh)
#pragma unroll
        for (int gi = 0; gi < 4; ++gi) { const f32x4 nv = *(const f32x4*)(ng + hh * 64 + 8 * gi);
            v2u w; w.x = cvtpk(gq[hh][4 * gi] * rn * nv[0], gq[hh][4 * gi + 1] * rn * nv[1]); w.y = cvtpk(gq[hh][4 * gi + 2] * rn * nv[2], gq[hh][4 * gi + 3] * rn * nv[3]);
            *(GAS v2u*)(yo + hh * 64 + 8 * gi) = w; }
    __syncthreads();
}
}
__device__ __forceinline__ void p2_ssd1(Frame& F, KArgs a, int l) {
    FRAME_IDS;
    gu32* head = (gu32*)(F.ws + WS_CTL) + CW_Q + 64 * (2 + l); volatile LAS unsigned* MISC = (volatile LAS unsigned*)(F.lds + MISC_OFF);
    for (int it = 0;; ++it) {
        if (tid == 0) MISC[18 + (it & 1)] = __hip_atomic_fetch_add(head, 1u, RLX_AGENT);
        __syncthreads();
        const int u = (int)MISC[18 + (it & 1)];
        if (u >= ssd::N_UNITS) break;
        int wv = F.wave; asm volatile("" : "+s"(wv)); const int ln = lane_id();
        ssd::pass1_unit(u, a, l, F.ws, F.lds, wv, ln);
    }
}

__device__ __forceinline__ void p3_mixers(Frame& F, KArgs a, int l) {
    FRAME_IDS;
    gu32* head = (gu32*)(F.ws + WS_CTL) + CW_Q + 64 * l;     volatile LAS unsigned* MISC = (volatile LAS unsigned*)(F.lds + MISC_OFF);
    const bf16* qkv = (const bf16*)(F.dout + DO_QKV); const bf16* proj = (const bf16*)(F.ws + WS_PROJ); bf16* y = (bf16*)(F.ws + WS_Y);
    for (int it = 0;; ++it) {
        if (tid == 0) MISC[16 + (it & 1)] = __hip_atomic_fetch_add(head, 1u, RLX_AGENT);
        __syncthreads();
        const int u = (int)MISC[16 + (it & 1)];
        if (u >= N_ATT_UNITS + ssd::N_UNITS) break;
        int wv = F.wave; asm volatile("" : "+s"(wv)); const int ln = lane_id();
        if (u < N_ATT_UNITS) { const int qb = 7 - u / (BATCH * NHEAD), bh = u % (BATCH * NHEAD);
            att::attn_unit(bh / NHEAD, bh % NHEAD, qb, qkv, proj, y, F.lds, wv, ln); }
        else ssd::pass2_unit(u - N_ATT_UNITS, a, l, F.ws, F.lds, wv, ln);
    }
}

__device__ __forceinline__ void p3_attn_naive(Frame& F) {
    FRAME_IDS;
    const bf16* qkv = (const bf16*)(F.dout + DO_QKV); const bf16* proj = (const bf16*)(F.ws + WS_PROJ); bf16* y = (bf16*)(F.ws + WS_Y);
    const int total = BATCH * NHEAD * SEQ;
    for (int e = F.bid * NTHR + tid; e < total; e += F.G * NTHR) {
        const int q = e % SEQ, h = (e / SEQ) % NHEAD, b = e / (SEQ * NHEAD); const size_t r = (size_t)b * SEQ + q;
        unsigned qp[48]; float o[64];
#pragma unroll
        for (int d = 0; d < 32; ++d) qp[d] = *(const GAS unsigned*)(qkv + r * NQKV + QC_QN + h * 64 + 2 * d);
#pragma unroll
        for (int d = 0; d < 16; ++d) qp[32 + d] = *(const GAS unsigned*)(qkv + r * NQKV + QC_QR + h * 32 + 2 * d);
#pragma unroll
        for (int d = 0; d < 64; ++d) o[d] = 0.f;
        float m = -INFINITY, lsum = 0.f;
        for (int j = 0; j <= q; ++j) {
            const size_t rj = (size_t)b * SEQ + j; const bf16* kn = qkv + rj * NQKV + QC_KN + h * 64; const bf16* kr = proj + rj * NP + PC_KR; const bf16* vv = qkv + rj * NQKV + QC_V + h * 64;
            float s = 0.f;
#pragma unroll
            for (int d = 0; d < 32; ++d) { const unsigned w = *(const GAS unsigned*)(kn + 2 * d); s += bflo(qp[d]) * bflo(w) + bfhi(qp[d]) * bfhi(w); }
#pragma unroll
            for (int d = 0; d < 16; ++d) { const unsigned w = *(const GAS unsigned*)(kr + 2 * d); s += bflo(qp[32 + d]) * bflo(w) + bfhi(qp[32 + d]) * bfhi(w); }
            const float mn = fmaxf(m, s), f = exp2f(m - mn), p = exp2f(s - mn);
            lsum = lsum * f + p; m = mn;
#pragma unroll
            for (int d = 0; d < 64; d += 2) { const unsigned w = *(const GAS unsigned*)(vv + d); o[d] = o[d] * f + p * bflo(w); o[d + 1] = o[d + 1] * f + p * bfhi(w); }
        }
        const float inv = 1.f / lsum; const bf16* cz = proj + r * NP + PC_CZ + h * 64;
#pragma unroll
        for (int d = 0; d < 64; ++d) y[r * DM + YC_C + h * 64 + d] = (bf16)f2bf(o[d] * inv * silu_f(bf2f(cz[d])));
    }
}
__device__ __forceinline__ void p3_ssd_naive(Frame& F, KArgs a, int l) {
    FRAME_IDS;
    const bf16* proj = (const bf16*)(F.ws + WS_PROJ); const float* dtb = (const float*)(F.ws + WS_DT); float* ys = (float*)(F.ws + WS_ST);
    const float* cw = a->ssd_conv_w + (size_t)l * 4 * 896; const float* cb = a->ssd_conv_b + (size_t)l * 896;
    LAS float* bc = (LAS float*)F.lds;
    for (int u = F.bid; u < BATCH * SSD_G; u += F.G) {
        const int b = u / SSD_G, g = u % SSD_G;
        const int hh = tid / 64, p = tid % 64, h = g * 3 + hh;
        float st[128];
#pragma unroll
        for (int n = 0; n < 128; ++n) st[n] = 0.f;
        const float A = tid < 192 ? -__expf(a->ssd_a_log[l * 6 + h]) : 0.f, Dk = tid < 192 ? a->ssd_d[l * 6 + h] : 0.f, dtbias = tid < 192 ? a->ssd_dt_bias[l * 6 + h] : 0.f;
        const int xc = hh * 64 + p + g * 192;
        for (int s = 0; s < SEQ; ++s) {
            const size_t r = (size_t)b * SEQ + s;
            if (tid < 256) {
                const int ch = tid < 128 ? 384 + g * 128 + tid : 640 + g * 128 + (tid - 128);
                const int pc = tid < 128 ? PC_SB + g * 128 + tid : PC_SC + g * 128 + (tid - 128);
                float v = cb[ch];
#pragma unroll
                for (int k = 0; k < 4; ++k) { const int ds = s - 3 + k; if (ds >= 0) v += cw[k * 896 + ch] * bf2f(proj[(r - 3 + k) * NP + pc]); }
                bc[tid] = silu_f(v);
            }
            __syncthreads();
            if (tid < 192) {
                float xv = cb[xc];
#pragma unroll
                for (int k = 0; k < 4; ++k) { const int ds = s - 3 + k; if (ds >= 0) xv += cw[k * 896 + xc] * bf2f(proj[(r - 3 + k) * NP + PC_SX + xc]); }
                xv = silu_f(xv);
                const float dt = softplus_f(dtb[r * 8 + h] + dtbias), dec = __expf(dt * A), xd = xv * dt;
                float yv = 0.f;
#pragma unroll
                for (int n = 0; n < 128; ++n) { st[n] = st[n] * dec + xd * bc[n]; yv += st[n] * bc[128 + n]; }
                ys[r * 384 + xc] = yv + xv * Dk;
            }
            __syncthreads();
        }
    }
}
__device__ __forceinline__ void p3b_ssd_gate_naive(Frame& F, KArgs a, int l) {
    FRAME_IDS;
    const bf16* proj = (const bf16*)(F.ws + WS_PROJ); const float* ys = (const float*)(F.ws + WS_ST); bf16* y = (bf16*)(F.ws + WS_Y);
    const float* ng = a->ssd_norm_g + (size_t)l * 384;
    const int gw = F.bid * NWAVES + F.wave, NGW = F.G * NWAVES;
    for (int e = gw; e < T * 2; e += NGW) {
        const int r = e >> 1, g = e & 1; float v[3]; float s = 0.f;
#pragma unroll
        for (int j = 0; j < 3; ++j) { const int c = g * 192 + lane + 64 * j; v[j] = ys[(size_t)r * 384 + c] * silu_f(bf2f(proj[(size_t)r * NP + PC_SZ + c])); s += v[j] * v[j]; }
        s = wave_sum(s); const float rn = 1.0f / sqrtf(s * (1.0f / 192.f) + SSD_NORM_EPS);
#pragma unroll
        for (int j = 0; j < 3; ++j) { const int c = g * 192 + lane + 64 * j; y[(size_t)r * DM + YC_B + c] = (bf16)f2bf(v[j] * rn * ng[c]); }
    }
}
__device__ __forceinline__ void p5_final(Frame& F, KArgs a) {
    FRAME_IDS;
    const float* ssq = (const float*)(F.ws + WS_SSQ);
    const int gw = F.bid * NWAVES + F.wave, NGW = F.G * NWAVES;
    for (int m = gw; m < T; m += NGW) {
        GAS f32x4* xr = (GAS f32x4*)(a->out + (size_t)m * DM) + lane; const GAS f32x4* gr = (const GAS f32x4*)a->final_norm_g + lane;
        const float s = (ssq[m] + ssq[T + m]) + (ssq[2 * T + m] + ssq[3 * T + m]); const float rs = 1.0f / sqrtf(s * (1.0f / DM) + NORM_EPS);
#pragma unroll
        for (int j = 0; j < 4; ++j) { const f32x4 v = xr[64 * j], g = gr[64 * j]; xr[64 * j] = v * rs * g; }
    }
}

constexpr int PH_PER_LAYER = 5, N_PHASES = 1 + DEPTH * PH_PER_LAYER + 1;
__global__ void __launch_bounds__(NTHR, 2) fwd_kernel(Args args) {
    extern __shared__ __attribute__((aligned(16))) unsigned char lds[];
    Frame F;
    F.lds = (LAS unsigned char*)lds; F.wave = __builtin_amdgcn_readfirstlane((int)threadIdx.x >> 6);
    const KArgs ka0 = (KArgs)__builtin_amdgcn_kernarg_segment_ptr();
#define KA() ({ KArgs p_ = ka0; asm volatile("" : "+s"(p_)); p_; })
    F.G = gridDim.x; F.bid = blockIdx.x; F.ws = ka0->ws; F.dout = (unsigned char*)ka0->out;
    volatile LAS unsigned* MISC = (volatile LAS unsigned*)(F.lds + MISC_OFF);
    if (threadIdx.x < 32) MISC[threadIdx.x] = 0u;
    __syncthreads();
    gu32* ctl = (gu32*)(F.ws + WS_CTL);
    XcdBarrier bar; bar.bar = (unsigned*)(ctl + CW_BAR); bar.x = 0; bar.st = nullptr;
    const int lo = ka0->ph_lo, hi = ka0->ph_hi;
    const bool multi = (hi - lo) > 1;
    if (multi) bar = xcd_barrier_post((unsigned*)(ctl + CW_BAR), MISC + 8, threadIdx.x == 0);
#define IN(k) (lo <= (k) && (k) < hi)
#define SEAM(k) do { if (IN(k) && IN((k) + 1)) xcd_barrier(bar, F.wave == 0 && lane_id() == 0); } while (0)
    if (IN(0)) { p0_prologue(F, KA()); } SEAM(0);
#define LAYER(l) do { constexpr int pb = 1 + (l) * PH_PER_LAYER; \
        if (IN(pb + 0)) { p1_inproj(F, KA(), l); } SEAM(pb + 0); \
        if (IN(pb + 1)) { p2_qkv(F, l); p2_ssd1(F, KA(), l); p2_conva(F, KA(), l); } SEAM(pb + 1); \
        if (IN(pb + 2)) { ssd::scan_phase(F); } SEAM(pb + 2); \
        if (IN(pb + 3)) { p3_mixers(F, KA(), l); } SEAM(pb + 3); \
        if (IN(pb + 4)) { p4_outproj(F, KA(), l); } SEAM(pb + 4); } while (0)
    LAYER(0);
    LAYER(1);
    static_assert(DEPTH == 2, "two layers written out");
#undef LAYER
    if (IN(N_PHASES - 1)) p5_final(F, KA());
#undef IN
#undef SEAM
}

extern "C" void kernel_launch(void* const* d_in, const int* in_sizes, int n_in, void* d_out, int out_size, void* d_ws, size_t ws_size, hipStream_t stream) {
    static int grid = 0;
    if (grid == 0) {
        if (n_in != 17 || in_sizes[0] != T * DM || out_size != T * DM || ws_size < WS_END) { fprintf(stderr, "kernel_launch: unexpected shapes (n_in %d, in0 %d, out %d, ws %zu)\n", n_in, n_in > 0 ? in_sizes[0] : -1, out_size, ws_size); grid = -1; return; }
        int dev = 0, cus = 0;
        if (hipGetDevice(&dev) != hipSuccess || hipDeviceGetAttribute(&cus, hipDeviceAttributeMultiprocessorCount, dev) != hipSuccess) { grid = -1; return; }
        if (hipFuncSetAttribute((const void*)fwd_kernel, hipFuncAttributeMaxDynamicSharedMemorySize, LDS_BYTES) != hipSuccess) { fprintf(stderr, "kernel_launch: hipFuncSetAttribute failed\n"); grid = -1; return; }
        int per_cu = 0;
        if (hipOccupancyMaxActiveBlocksPerMultiprocessor(&per_cu, (const void*)fwd_kernel, NTHR, LDS_BYTES) != hipSuccess || per_cu < 1) fprintf(stderr, "kernel_launch: occupancy query reports %d\n", per_cu);
        (void)hipGetLastError();
        grid = cus;
    }
    if (grid < 0) return;
    (void)hipMemsetAsync((char*)d_ws + WS_CTL, 0, CTL_ZERO_BYTES, stream);
    Args a{};
    a.x = (const float*)d_in[0]; a.pos = (const int*)d_in[1]; a.norm_g = (const float*)d_in[2]; a.w_in = (const float*)d_in[3]; a.conv_a_w = (const float*)d_in[4];
    a.ssd_conv_w = (const float*)d_in[5]; a.ssd_conv_b = (const float*)d_in[6]; a.ssd_dt_bias = (const float*)d_in[7]; a.ssd_a_log = (const float*)d_in[8]; a.ssd_d = (const float*)d_in[9];
    a.ssd_norm_g = (const float*)d_in[10]; a.mla_q_norm_g = (const float*)d_in[11]; a.w_qb = (const float*)d_in[12]; a.mla_kv_norm_g = (const float*)d_in[13]; a.w_kvb = (const float*)d_in[14];
    a.w_out = (const float*)d_in[15]; a.final_norm_g = (const float*)d_in[16];
    a.out = (float*)d_out; a.ws = (unsigned char*)d_ws;
#if MK_N_LAUNCHES == 1
    a.ph_lo = 0; a.ph_hi = N_PHASES;
    hipLaunchKernelGGL(fwd_kernel, dim3(grid), dim3(NTHR), LDS_BYTES, stream, a);
#else
    for (int ph = 0; ph < N_PHASES; ++ph) { a.ph_lo = ph; a.ph_hi = ph + 1; hipLaunchKernelGGL(fwd_kernel, dim3(grid), dim3(NTHR), LDS_BYTES, stream, a); }
#endif
}
```
